# Optimizing an MI355X kernel written in HIP

```python
import numpy as np
import jax
import jax.numpy as jnp
from jax import lax

D_MODEL = 2048
BATCH = 4
SEQ = 2048
DEPTH = 4

EPS = 1e-6
NEG = -1e30
D_FF = 5632
Q_BLOCK = 128

A_GROUPS = ((128, 1), (512, 4), (2048, 16))
A_HEADS_PER_GROUP = 4
A_HEADS = A_HEADS_PER_GROUP * len(A_GROUPS)
A_HEAD_DIM = 64
A_WIDTH = A_HEADS * A_HEAD_DIM
A_OUT = A_HEADS_PER_GROUP * A_HEAD_DIM

B_WINDOWS = (2, 4, 8, 16)
B_GROUP_DIM = 128
B_WIDTH = B_GROUP_DIM * len(B_WINDOWS)

C_KV_GROUPS = 2
C_HEADS_PER_GROUP = 3
C_HEADS = C_KV_GROUPS * C_HEADS_PER_GROUP
C_HEAD_DIM = 128
C_WIDTH = C_HEADS * C_HEAD_DIM
C_KV_WIDTH = C_KV_GROUPS * C_HEAD_DIM
CMP_LEN = 32
CMP_STRIDE = 16
SEL_BLOCK = 64
SEL_TOPN = 8
FORCE_BONUS = 100.0
WIN = 512

N_BRANCH = 3
COL_SIZES = (A_WIDTH, A_WIDTH, A_WIDTH, B_WIDTH, C_WIDTH, C_KV_WIDTH, C_KV_WIDTH, C_KV_WIDTH, C_KV_WIDTH, C_KV_WIDTH, C_KV_WIDTH, 3 * C_HEADS, N_BRANCH * D_MODEL)
IN_COLS = sum(COL_SIZES)

kernel_name = 'hybrid_dilated_pool_nsa_trunk'


def _rmsnorm(x, g):
    xf = x.astype(jnp.float32)
    y = xf * lax.rsqrt(jnp.mean(xf * xf, axis=-1, keepdims=True) + EPS)
    return y.astype(x.dtype) * g


def _swiglu(x, w_i, w_o):
    a, b = jnp.split(x @ w_i, 2, axis=-1)
    return (jax.nn.silu(a) * b) @ w_o


def _dilated_attention(q, k, v):
    bsz, s, _ = q.shape
    nq = s // Q_BLOCK
    shp = (bsz, s, len(A_GROUPS), A_HEADS_PER_GROUP, A_HEAD_DIM)
    qh = q.reshape(shp).transpose(2, 0, 3, 1, 4)
    kh = k.reshape(shp).transpose(2, 0, 3, 1, 4)
    vh = v.reshape(shp).transpose(2, 0, 3, 1, 4)
    scale = A_HEAD_DIM ** -0.5
    outs, lses = [], []
    for gi, (win, dil) in enumerate(A_GROUPS):
        offs = jnp.arange(win // dil + 1) * dil
        kg, vg = kh[gi], vh[gi]
        q_chunks = qh[gi].reshape(bsz, A_HEADS_PER_GROUP, nq, Q_BLOCK, A_HEAD_DIM).transpose(2, 0, 1, 3, 4)

        def block(args, kg=kg, vg=vg, offs=offs):
            q_blk, start = args
            t = start + jnp.arange(Q_BLOCK)
            idx = t[:, None] - offs[None, :]
            valid = idx >= 0
            idx = jnp.maximum(idx, 0)
            kk = jnp.take(kg, idx, axis=2)
            vv = jnp.take(vg, idx, axis=2)
            sc = jnp.einsum('bhqd,bhqkd->bhqk', q_blk, kk, preferred_element_type=jnp.float32) * scale
            sc = jnp.where(valid, sc, NEG)
            m = jnp.max(sc, axis=-1, keepdims=True)
            p = jnp.exp(sc - m)
            l = jnp.sum(p, axis=-1, keepdims=True)
            o = jnp.einsum('bhqk,bhqkd->bhqd', p, vv.astype(jnp.float32)) / l
            return o, (m + jnp.log(l))[..., 0]

        o, lse = lax.map(block, (q_chunks, jnp.arange(nq) * Q_BLOCK))
        outs.append(o.transpose(1, 2, 0, 3, 4).reshape(bsz, A_HEADS_PER_GROUP, s, A_HEAD_DIM))
        lses.append(lse.transpose(1, 2, 0, 3).reshape(bsz, A_HEADS_PER_GROUP, s))
    w = jax.nn.softmax(jnp.stack(lses), axis=0)
    o = jnp.sum(w[..., None] * jnp.stack(outs), axis=0)
    return o.transpose(0, 2, 1, 3).reshape(bsz, s, A_OUT).astype(q.dtype)


def _pool_mixer(v, w_pool, scale):
    bsz, s, _ = v.shape
    vf = v.astype(jnp.float32).reshape(bsz, s, len(B_WINDOWS), B_GROUP_DIM)
    csum = jnp.concatenate([jnp.zeros_like(vf[:, :1]), jnp.cumsum(vf, axis=1)], axis=1)
    t = jnp.arange(s)
    pooled = []
    for gi, w in enumerate(B_WINDOWS):
        lo = jnp.maximum(t + 1 - w, 0)
        cnt = (t + 1 - lo).astype(jnp.float32)
        seg = csum[:, t + 1, gi] - csum[:, lo, gi]
        pooled.append(seg / cnt[None, :, None] - vf[:, :, gi])
    z = jnp.stack(pooled, axis=2).astype(v.dtype)
    z = jnp.einsum('bsgc,gcd->bsgd', z, w_pool)
    return z.reshape(bsz, s, B_WIDTH) * scale


def _nsa(q, k_cmp, v_cmp, k_slc, v_slc, k_win, v_win, gates, pe_k, w1_k, w2_k, pe_v, w1_v, w2_v):
    bsz, s, _ = q.shape
    G, Hg, dh = C_KV_GROUPS, C_HEADS_PER_GROUP, C_HEAD_DIM
    scale = dh ** -0.5
    nq = s // Q_BLOCK
    qh = q.reshape(bsz, s, G, Hg, dh).transpose(0, 2, 3, 1, 4)

    def kvh(z):
        return z.reshape(bsz, s, G, dh).transpose(0, 2, 1, 3)

    t = jnp.arange(s)

    n_cmp = (s - CMP_LEN) // CMP_STRIDE + 1
    blk = np.arange(n_cmp)[:, None] * CMP_STRIDE + np.arange(CMP_LEN)[None, :]

    def compress(z, pe, w1, w2):
        zb = kvh(z)[:, :, blk] + pe
        return jax.nn.gelu(zb.reshape(bsz, G, n_cmp, CMP_LEN * dh) @ w1) @ w2

    kc = compress(k_cmp, pe_k, w1_k, w2_k)
    vc = compress(v_cmp, pe_v, w1_v, w2_v)
    cmp_end = np.arange(n_cmp) * CMP_STRIDE + CMP_LEN - 1
    cvalid = cmp_end[None, :] <= t[:, None]
    sc = jnp.einsum('bgnsd,bgcd->bgnsc', qh, kc, preferred_element_type=jnp.float32) * scale
    sc = jnp.where(cvalid, sc, NEG)
    p_cmp = jnp.where(cvalid, jax.nn.softmax(sc, axis=-1), 0.0)
    o_cmp = jnp.einsum('bgnsc,bgcd->bgnsd', p_cmp, vc.astype(jnp.float32))

    nb = s // SEL_BLOCK
    ci = np.arange(n_cmp)[:, None] * CMP_STRIDE
    bj = np.arange(nb)[None, :] * SEL_BLOCK
    overlap = ((ci < bj + SEL_BLOCK) & (ci + CMP_LEN > bj)).astype(np.float32)
    imp = jnp.einsum('bgnsc,cj->bgsj', p_cmp, overlap)
    jb = np.arange(nb)[None, :]
    tb = (t // SEL_BLOCK)[:, None]
    forced = (jb == 0) | (jb == tb) | (jb == tb - 1)
    score = jnp.where(jb > tb, -1.0, imp + jnp.where(forced, FORCE_BONUS, 0.0))
    k_sel = min(SEL_TOPN, nb)
    _, sel_idx = lax.top_k(score, k_sel)

    ks = kvh(k_slc).reshape(bsz, G, nb, SEL_BLOCK, dh)
    vs = kvh(v_slc).reshape(bsz, G, nb, SEL_BLOCK, dh)
    q_chunks = qh.reshape(bsz, G, Hg, nq, Q_BLOCK, dh).transpose(3, 0, 1, 2, 4, 5)
    idx_chunks = sel_idx.reshape(bsz, G, nq, Q_BLOCK, k_sel).transpose(2, 0, 1, 3, 4)
    gather = jax.vmap(jax.vmap(lambda blocks, ix: blocks[ix]))

    def sel_block(args):
        q_blk, ix, start = args
        tq = start + jnp.arange(Q_BLOCK)
        flat = ix.reshape(bsz, G, Q_BLOCK * k_sel)
        kk = gather(ks, flat).reshape(bsz, G, Q_BLOCK, k_sel * SEL_BLOCK, dh)
        vv = gather(vs, flat).reshape(bsz, G, Q_BLOCK, k_sel * SEL_BLOCK, dh)
        kpos = (ix[..., None] * SEL_BLOCK + jnp.arange(SEL_BLOCK)).reshape(bsz, G, Q_BLOCK, k_sel * SEL_BLOCK)
        valid = kpos <= tq[None, None, :, None]
        sc_s = jnp.einsum('bgnqd,bgqkd->bgnqk', q_blk, kk, preferred_element_type=jnp.float32) * scale
        sc_s = jnp.where(valid[:, :, None], sc_s, NEG)
        p = jax.nn.softmax(sc_s, axis=-1)
        return jnp.einsum('bgnqk,bgqkd->bgnqd', p, vv.astype(jnp.float32))

    o_slc = lax.map(sel_block, (q_chunks, idx_chunks, jnp.arange(nq) * Q_BLOCK))
    o_slc = o_slc.transpose(1, 2, 3, 0, 4, 5).reshape(bsz, G, Hg, s, dh)

    nband = WIN // Q_BLOCK + 1

    def band(z):
        zp = jnp.pad(kvh(z), ((0, 0), (0, 0), (WIN, 0), (0, 0))).reshape(bsz, G, nq + nband - 1, Q_BLOCK, dh)
        return jnp.concatenate([zp[:, :, j:j + nq] for j in range(nband)], axis=3)

    kw = band(k_win)
    vw = band(v_win)
    qb = qh.reshape(bsz, G, Hg, nq, Q_BLOCK, dh)
    qpos = np.arange(nq)[:, None] * Q_BLOCK + np.arange(Q_BLOCK)[None, :]
    kpos = np.arange(nq)[:, None] * Q_BLOCK - WIN + np.arange(nband * Q_BLOCK)[None, :]
    wvalid = (kpos[:, None, :] <= qpos[:, :, None]) & (kpos[:, None, :] > qpos[:, :, None] - WIN) & (kpos[:, None, :] >= 0)
    sc_w = jnp.einsum('bgnicd,bgikd->bgnick', qb, kw, preferred_element_type=jnp.float32) * scale
    sc_w = jnp.where(wvalid, sc_w, NEG)
    p_w = jax.nn.softmax(sc_w, axis=-1)
    o_win = jnp.einsum('bgnick,bgikd->bgnicd', p_w, vw.astype(jnp.float32)).reshape(bsz, G, Hg, s, dh)

    g = jax.nn.sigmoid(gates.astype(jnp.float32)).reshape(bsz, s, G, Hg, 3).transpose(0, 2, 3, 1, 4)
    o = g[..., 0:1] * o_cmp + g[..., 1:2] * o_slc + g[..., 2:3] * o_win
    return o.transpose(0, 3, 1, 2, 4).reshape(bsz, s, C_WIDTH).astype(q.dtype)


def _mixing(u, w_in, pool_w, pool_scale, pe_k, w1_k, w2_k, pe_v, w1_v, w2_v, proj_a, proj_b, proj_c, w_out):
    bsz, s, _ = u.shape
    splits = np.cumsum(COL_SIZES)[:-1].tolist()
    qa, ka, va, xb, qc, kcmp, vcmp, kslc, vslc, kwin, vwin, gc, gm = jnp.split(u @ w_in, splits, axis=-1)
    ya = _dilated_attention(qa, ka, va) @ proj_a
    yb = _pool_mixer(xb, pool_w, pool_scale) @ proj_b
    yc = _nsa(qc, kcmp, vcmp, kslc, vslc, kwin, vwin, gc, pe_k, w1_k, w2_k, pe_v, w1_v, w2_v) @ proj_c
    g = jax.nn.sigmoid(gm.reshape(bsz, s, N_BRANCH, D_MODEL))
    return (g[:, :, 0] * ya + g[:, :, 1] * yb + g[:, :, 2] * yc) @ w_out


def setup_inputs(seed: int = 0) -> dict:
    key = jax.random.key(seed)
    ks = jax.random.split(key, 24)
    f32 = jnp.float32

    def dense(k, shape):
        return jax.random.normal(k, shape, f32) * (shape[-2] ** -0.5)

    def gain(k, shape):
        return 1.0 + 0.02 * jax.random.normal(k, shape, f32)

    L = DEPTH
    cdim = CMP_LEN * C_HEAD_DIM
    return {
        'x': jax.random.normal(ks[0], (BATCH, SEQ, D_MODEL), f32),
        'ffn1_norm': gain(ks[1], (L, D_MODEL)),
        'ffn1_wi': dense(ks[2], (L, D_MODEL, 2 * D_FF)),
        'ffn1_wo': dense(ks[3], (L, D_FF, D_MODEL)),
        'mix_norm': gain(ks[4], (L, D_MODEL)),
        'w_in': dense(ks[5], (L, D_MODEL, IN_COLS)),
        'pool_w': dense(ks[6], (L, len(B_WINDOWS), B_GROUP_DIM, B_GROUP_DIM)),
        'pool_scale': gain(ks[7], (L, B_WIDTH)),
        'cmp_pe_k': 0.02 * jax.random.normal(ks[8], (L, CMP_LEN, C_HEAD_DIM), f32),
        'cmp_w1_k': dense(ks[9], (L, cdim, C_HEAD_DIM)),
        'cmp_w2_k': dense(ks[10], (L, C_HEAD_DIM, C_HEAD_DIM)),
        'cmp_pe_v': 0.02 * jax.random.normal(ks[11], (L, CMP_LEN, C_HEAD_DIM), f32),
        'cmp_w1_v': dense(ks[12], (L, cdim, C_HEAD_DIM)),
        'cmp_w2_v': dense(ks[13], (L, C_HEAD_DIM, C_HEAD_DIM)),
        'proj_a': dense(ks[14], (L, A_OUT, D_MODEL)),
        'proj_b': dense(ks[15], (L, B_WIDTH, D_MODEL)),
        'proj_c': dense(ks[16], (L, C_WIDTH, D_MODEL)),
        'w_out': dense(ks[17], (L, D_MODEL, D_MODEL)),
        'ffn2_norm': gain(ks[18], (L, D_MODEL)),
        'ffn2_wi': dense(ks[19], (L, D_MODEL, 2 * D_FF)),
        'ffn2_wo': dense(ks[20], (L, D_FF, D_MODEL)),
        'final_norm': gain(ks[21], (D_MODEL,)),
    }


def reference(x, ffn1_norm, ffn1_wi, ffn1_wo, mix_norm, w_in, pool_w, pool_scale, cmp_pe_k, cmp_w1_k, cmp_w2_k, cmp_pe_v, cmp_w1_v, cmp_w2_v, proj_a, proj_b, proj_c, w_out, ffn2_norm, ffn2_wi, ffn2_wo, final_norm):
    for l in range(DEPTH):
        x = x + 0.5 * _swiglu(_rmsnorm(x, ffn1_norm[l]), ffn1_wi[l], ffn1_wo[l])
        x = x + _mixing(_rmsnorm(x, mix_norm[l]), w_in[l], pool_w[l], pool_scale[l], cmp_pe_k[l], cmp_w1_k[l], cmp_w2_k[l], cmp_pe_v[l], cmp_w1_v[l], cmp_w2_v[l], proj_a[l], proj_b[l], proj_c[l], w_out[l])
        x = x + 0.5 * _swiglu(_rmsnorm(x, ffn2_norm[l]), ffn2_wi[l], ffn2_wo[l])
    return _rmsnorm(x, final_norm)
```

```cpp
#include <hip/hip_runtime.h>
#include <cstdio>
#include <cstdint>
namespace pg8 {
#define PG8_LAS __attribute__((address_space(3)))
typedef unsigned short bf16_t;
typedef short bf16x8 __attribute__((ext_vector_type(8)));
typedef float f32x4 __attribute__((ext_vector_type(4)));
typedef unsigned u32x4 __attribute__((ext_vector_type(4)));
constexpr int BM = 256, BK = 64, HALF = 128, HTB = HALF * BK * 2  , STAGE_BYTES = 8 * HTB, NXCD = 8, WGM = 8;

__host__ __device__ __forceinline__ int lds_byte(int r, int c) { const int st = (r >> 4) * 2 + (c >> 5), rr = r & 15, cc = c & 31, ob = rr * 64 + cc * 2; return st * 1024 + (ob ^ (((ob >> 9) & 1) << 5)); }
__host__ __device__ __forceinline__ void stage_rc(int b, int& R, int& C) { const int st = b / 1024, sb = b % 1024, swz = sb ^ (((sb >> 9) & 1) << 5); R = (st >> 1) * 16 + swz / 64; C = (st & 1) * 32 + (swz % 64) / 2; }
__host__ __device__ __forceinline__ int perm32(int rho) { const int n = rho >> 4, i = rho & 15; return 8 * (i >> 2) + 4 * n + (i & 3); }

struct Unit { int pm, pn; };
struct Gemm { const bf16_t* A; const bf16_t* Bt; int M, N, K, lda, ldb; };

struct StaticOrder {
    int nM, nN, nwg, G, c;
    __host__ __device__ void init(int M, int N, int G_, int c_) { nM = M / BM; nN = N / BM; nwg = nM * nN; G = G_; c = c_; }
    __host__ __device__ bool next(int i, Unit& u) const {
        const long L = (long)i * G + c; if (L >= nwg) return false;
        int wgid = (int)L; { const int q = nwg / NXCD, r = nwg % NXCD, xcd = wgid % NXCD, off = wgid / NXCD; wgid = (xcd < r ? xcd * (q + 1) : r * (q + 1) + (xcd - r) * q) + off; }
        const int nig = WGM * nN, gid = wgid / nig, fm = gid * WGM, gsz = (nM - fm) < WGM ? (nM - fm) : WGM;
        u.pm = fm + ((wgid % nig) % gsz); u.pn = (wgid % nig) / gsz; return true;
    }
    __device__ __forceinline__ void a_ready(const Unit&) const {}
    __device__ __forceinline__ void done(const Unit&) const {}
};

template <class Epi, class Sched, bool ALIGN_EPI = false, bool SP2 = false>
__device__ __forceinline__ void gemm_phase(PG8_LAS unsigned char* lds, const Gemm g, const Sched& S, const Epi& E) {
    int tid_l = (int)threadIdx.x; asm volatile("" : "+v"(tid_l));
    const int tid = tid_l, wid = __builtin_amdgcn_readfirstlane(tid >> 6), lane = tid & 63, wr = wid >> 2, wc = wid & 3, fr = lane & 15, fq = lane >> 4;
    const int K = g.K, nt = K / BK;
    unsigned voffA[2], voffB[2];
#pragma unroll
    for (int i = 0; i < 2; ++i) { int R, C; stage_rc(tid * 16 + i * 8192, R, C); const int Rb = Epi::PERM ? ((R & ~31) + perm32(R & 31)) : R;
        voffA[i] = (unsigned)(R * g.lda + C) * 2u; voffB[i] = (unsigned)(Rb * g.ldb + C) * 2u; }
    const size_t kstep = (size_t)(BK * 2);
    const size_t hstepA = (size_t)HALF * g.lda * 2, hstepB = (size_t)HALF * g.ldb * 2;
    const size_t tstepA = 2 * hstepA, tstepB = 2 * hstepB;
    const unsigned ldsw = (unsigned)wid * 1024u;
    const int aoff = lds_byte(wr * 64 + fr, fq * 8), boff = lds_byte(wc * 32 + fr, fq * 8);
#define PG8_SA(b, h) (((b) * 2 + (h)) * HTB)
#define PG8_SB(b, h) ((4 + (b) * 2 + (h)) * HTB)
#define PG8_STAGE(bufoff, gbase, voff) do { _Pragma("unroll") for (int _i = 0; _i < 2; ++_i) \
        __builtin_amdgcn_global_load_lds((const unsigned*)((const char*)(gbase) + (voff)[_i]), (PG8_LAS unsigned*)(lds + (bufoff) + ldsw + _i * 8192), 16, 0, 0); } while (0)
#define PG8_LDA(dst, b, h) do { _Pragma("unroll") for (int m = 0; m < 4; ++m) _Pragma("unroll") for (int k = 0; k < 2; ++k) dst[m][k] = *(const PG8_LAS bf16x8*)(lds + PG8_SA(b, h) + aoff + m * 2048 + k * 1024); } while (0)
#define PG8_LDB(dst, b, h) do { _Pragma("unroll") for (int n = 0; n < 2; ++n) _Pragma("unroll") for (int k = 0; k < 2; ++k) dst[n][k] = *(const PG8_LAS bf16x8*)(lds + PG8_SB(b, h) + boff + n * 2048 + k * 1024); } while (0)
#define PG8_MMA(ai, bj, At, Bt) do { __builtin_amdgcn_s_setprio(1); _Pragma("unroll") for (int m = 0; m < 4; ++m) _Pragma("unroll") for (int n = 0; n < 2; ++n) _Pragma("unroll") for (int k = 0; k < 2; ++k) \
        acc[ai][bj][m][n] = __builtin_amdgcn_mfma_f32_16x16x32_bf16(Bt[n][k], At[m][k], acc[ai][bj][m][n], 0, 0, 0); __builtin_amdgcn_s_setprio(0); } while (0)
#define PG8_WAIT_V(n) asm volatile("s_waitcnt vmcnt(" #n ")" ::: "memory")
#define PG8_WAIT_L(n) asm volatile("s_waitcnt lgkmcnt(" #n ")" ::: "memory")
#define PG8_BAR __builtin_amdgcn_s_barrier()
#define PG8_SCHED __builtin_amdgcn_sched_barrier(0)
    Unit cur, nxt; int ui = 0;
    if (!S.next(0, cur)) return;
    f32x4 acc[2][2][4][2];
#pragma unroll
    for (int a = 0; a < 2; ++a)
#pragma unroll
        for (int b = 0; b < 2; ++b)
#pragma unroll
            for (int m = 0; m < 4; ++m)
#pragma unroll
                for (int n = 0; n < 2; ++n) acc[a][b][m][n] = (f32x4){0.f, 0.f, 0.f, 0.f};
    bf16x8 At[4][2], B0[2][2], B1[2][2];
    const char* cA = (const char*)g.A + (size_t)cur.pm * tstepA; const char* cB = (const char*)g.Bt + (size_t)cur.pn * tstepB;
    S.a_ready(cur);
    if constexpr (SP2) {
        PG8_STAGE(PG8_SB(0, 0), cB, voffB); PG8_STAGE(PG8_SB(0, 1), cB + hstepB, voffB); PG8_STAGE(PG8_SA(0, 0), cA, voffA); PG8_STAGE(PG8_SA(0, 1), cA + hstepA, voffA);
        if (wr == 1) PG8_BAR;
        PG8_WAIT_V(2); PG8_BAR;
        PG8_STAGE(PG8_SB(1, 0), cB + kstep, voffB); PG8_STAGE(PG8_SA(1, 0), cA + kstep, voffA); PG8_STAGE(PG8_SB(1, 1), cB + hstepB + kstep, voffB);
        PG8_WAIT_V(6); PG8_BAR;
    } else {
        PG8_STAGE(PG8_SB(0, 0), cB, voffB); PG8_STAGE(PG8_SA(0, 0), cA, voffA); PG8_STAGE(PG8_SB(0, 1), cB + hstepB, voffB); PG8_STAGE(PG8_SA(0, 1), cA + hstepA, voffA);
        if (wr == 1) PG8_BAR;
        PG8_WAIT_V(4); PG8_BAR;
        PG8_STAGE(PG8_SB(1, 0), cB + kstep, voffB); PG8_STAGE(PG8_SA(1, 0), cA + kstep, voffA); PG8_STAGE(PG8_SB(1, 1), cB + hstepB + kstep, voffB);
        PG8_WAIT_V(6); PG8_BAR;
    }
    for (;;) {
        const bool has_next = S.next(ui + 1, nxt);
        const char* nA = has_next ? (const char*)g.A + (size_t)nxt.pm * tstepA : cA; const char* nB = has_next ? (const char*)g.Bt + (size_t)nxt.pn * tstepB : cB;
        for (int t = 0; t < nt; t += 2) {
            const bool last = (t == nt - 2);
            const char* a1 = cA + (size_t)(t + 1) * kstep;
            const char* a2 = last ? nA : cA + (size_t)(t + 2) * kstep; const char* b2 = last ? nB : cB + (size_t)(t + 2) * kstep;
            const char* a3 = a2 + kstep; const char* b3 = b2 + kstep;
            if (last && has_next) S.a_ready(nxt);
            if constexpr (SP2) {
            PG8_LDB(B0, 0, 0); PG8_LDB(B1, 0, 1); PG8_SCHED; PG8_LDA(At, 0, 0); PG8_STAGE(PG8_SA(1, 1), a1 + hstepA, voffA);
            PG8_WAIT_V(8); PG8_WAIT_L(0); PG8_BAR; PG8_MMA(0, 0, At, B0); PG8_MMA(0, 1, At, B1); PG8_BAR; PG8_SCHED;
            PG8_LDA(At, 0, 1); PG8_STAGE(PG8_SB(0, 0), b2, voffB); PG8_STAGE(PG8_SB(0, 1), b2 + hstepB, voffB); PG8_STAGE(PG8_SA(0, 0), a2, voffA);
            PG8_WAIT_V(8); PG8_WAIT_L(0); PG8_BAR; PG8_MMA(1, 0, At, B0); PG8_MMA(1, 1, At, B1); PG8_BAR; PG8_SCHED;
            PG8_LDB(B0, 1, 0); PG8_LDB(B1, 1, 1); PG8_SCHED; PG8_LDA(At, 1, 0); PG8_STAGE(PG8_SA(0, 1), a2 + hstepA, voffA);
            PG8_WAIT_V(8); PG8_WAIT_L(0); PG8_BAR; PG8_MMA(0, 0, At, B0); PG8_MMA(0, 1, At, B1); PG8_BAR; PG8_SCHED;
            PG8_LDA(At, 1, 1); PG8_STAGE(PG8_SB(1, 0), b3, voffB); PG8_STAGE(PG8_SB(1, 1), b3 + hstepB, voffB); PG8_STAGE(PG8_SA(1, 0), a3, voffA);
            PG8_WAIT_V(8); PG8_WAIT_L(0); PG8_BAR; PG8_MMA(1, 0, At, B0); PG8_MMA(1, 1, At, B1); PG8_BAR; PG8_SCHED;
            } else {
            PG8_LDB(B0, 0, 0); PG8_SCHED; PG8_LDA(At, 0, 0); PG8_STAGE(PG8_SA(1, 1), a1 + hstepA, voffA);
            PG8_WAIT_L(8); PG8_BAR; PG8_WAIT_L(0); PG8_MMA(0, 0, At, B0); PG8_BAR; PG8_SCHED;
            PG8_LDB(B1, 0, 1); PG8_STAGE(PG8_SB(0, 0), b2, voffB);
            PG8_BAR; PG8_WAIT_L(0); PG8_MMA(0, 1, At, B1); PG8_BAR;
            PG8_LDA(At, 0, 1); PG8_STAGE(PG8_SA(0, 0), a2, voffA);
            PG8_BAR; PG8_WAIT_L(0); PG8_MMA(1, 0, At, B0); PG8_BAR; PG8_SCHED;
            PG8_STAGE(PG8_SB(0, 1), b2 + hstepB, voffB);
            PG8_WAIT_V(6); PG8_BAR; PG8_MMA(1, 1, At, B1); PG8_BAR;
            PG8_LDB(B0, 1, 0); PG8_SCHED; PG8_LDA(At, 1, 0); PG8_STAGE(PG8_SA(0, 1), a2 + hstepA, voffA);
            PG8_WAIT_L(8); PG8_BAR; PG8_WAIT_L(0); PG8_MMA(0, 0, At, B0); PG8_BAR; PG8_SCHED;
            PG8_LDB(B1, 1, 1); PG8_STAGE(PG8_SB(1, 0), b3, voffB);
            PG8_BAR; PG8_WAIT_L(0); PG8_MMA(0, 1, At, B1); PG8_BAR;
            PG8_LDA(At, 1, 1); PG8_STAGE(PG8_SA(1, 0), a3, voffA);
            PG8_BAR; PG8_WAIT_L(0); PG8_MMA(1, 0, At, B0); PG8_BAR; PG8_SCHED;
            PG8_STAGE(PG8_SB(1, 1), b3 + hstepB, voffB);
            PG8_WAIT_V(6); PG8_BAR; PG8_MMA(1, 1, At, B1); PG8_BAR;
            }
        }
        if constexpr (ALIGN_EPI) { if (wr == 0) PG8_BAR; }
        if constexpr (!Epi::AFTER_DRAIN) { E(acc, cur, wr, wc, fr, fq); S.done(cur); }
        if (!has_next) break;
#pragma unroll
        for (int a = 0; a < 2; ++a)
#pragma unroll
            for (int b = 0; b < 2; ++b)
#pragma unroll
                for (int m = 0; m < 4; ++m)
#pragma unroll
                    for (int n = 0; n < 2; ++n) acc[a][b][m][n] = (f32x4){0.f, 0.f, 0.f, 0.f};
        cur = nxt; cA = nA; cB = nB; ++ui;
        if constexpr (ALIGN_EPI) { if (wr == 1) PG8_BAR; }
    }
    PG8_WAIT_V(0);
    if constexpr (!ALIGN_EPI) { if (wr == 0) PG8_BAR; }
    PG8_BAR;
    if constexpr (Epi::AFTER_DRAIN) { E.fused(acc, cur, wr, wc, fr, fq, lds, wid, lane); S.done(cur); }
#undef PG8_SA
#undef PG8_SB
#undef PG8_STAGE
#undef PG8_LDA
#undef PG8_LDB
#undef PG8_MMA
#undef PG8_WAIT_V
#undef PG8_WAIT_L
#undef PG8_BAR
#undef PG8_SCHED
}
}
#define GAS __attribute__((address_space(1)))
#define LAS __attribute__((address_space(3)))
typedef unsigned short bf16;
typedef unsigned v4u __attribute__((ext_vector_type(4)));
typedef float f32x4 __attribute__((ext_vector_type(4)));
typedef short bf16x8 __attribute__((ext_vector_type(8)));
typedef GAS unsigned gu32;
typedef GAS unsigned long long gu64;
#define RLX_AGENT __ATOMIC_RELAXED, __HIP_MEMORY_SCOPE_AGENT
#define LDS_WAIT() asm volatile("s_waitcnt lgkmcnt(0)" ::: "memory")
#define VM_WAIT() asm volatile("s_waitcnt vmcnt(0)" ::: "memory")
__device__ __forceinline__ unsigned long long rt() { return __builtin_amdgcn_s_memrealtime(); }
__device__ __forceinline__ unsigned f2bf(float f) { unsigned u = __builtin_bit_cast(unsigned, f); return (u + 0x7fffu + ((u >> 16) & 1u)) >> 16; }
__device__ __forceinline__ unsigned pk2(float lo, float hi) { return f2bf(lo) | (f2bf(hi) << 16); }

#define XB_TMO      128
#define XB_XCNT(j)  (256  + 64 * (j))
#define XB_XSUB(j)  (1280 + 64 * (j))
#define XB_XGEN(j)  (2304 + 64 * (j))
#define XB_TOP      3328
#define XB_TOPGEN   3392
#define XCD_BAR_WORDS 3456
#define XB_SPIN_CAP (1u << 18)

__device__ __forceinline__ unsigned xb_ld(unsigned* p)              { return __hip_atomic_load(p, __ATOMIC_RELAXED, __HIP_MEMORY_SCOPE_AGENT); }
__device__ __forceinline__ unsigned xb_add(unsigned* p, unsigned v) { return __hip_atomic_fetch_add(p, v, __ATOMIC_RELAXED, __HIP_MEMORY_SCOPE_AGENT); }
__device__ __forceinline__ unsigned xb_xcc_id() { return (unsigned)__builtin_amdgcn_s_getreg((3 << 11) | 20) & 0xFu; }
#define XB_SPIN(cond, bar) do { unsigned _sp = 0; while (cond) { __builtin_amdgcn_s_sleep(1); \
    if ((++_sp & 255u) == 0u) { if (xb_ld(&(bar)[XB_TMO])) break; if (_sp > XB_SPIN_CAP) { atomicAdd(&(bar)[XB_TMO], 1u); break; } } } } while (0)

struct XcdBarrier {
    unsigned* bar; unsigned x;
    volatile LAS unsigned* st;
};

__device__ __forceinline__ XcdBarrier xcd_barrier_post(unsigned* bar, volatile LAS unsigned* st) {
    XcdBarrier b; b.bar = bar; b.x = xb_xcc_id(); b.st = st;
    if (threadIdx.x == 0) (void)xb_add(&bar[XB_XCNT(b.x)], 1u);
    return b;
}
__device__ __forceinline__ void xcd_barrier_complete(unsigned* bar, unsigned x, unsigned& nloc, unsigned& nx) {
    const unsigned G = gridDim.x * gridDim.y * gridDim.z;
    unsigned sum, cnt, mine, sp = 0u;
    for (;;) {
        sum = 0u; cnt = 0u; mine = 0u;
#pragma unroll
        for (unsigned j = 0; j < 16; ++j) { const unsigned c = xb_ld(&bar[XB_XCNT(j)]); sum += c; cnt += (c > 0u) ? 1u : 0u; mine = (j == x) ? c : mine; }
        if (sum == G) break;
        __builtin_amdgcn_s_sleep(1);
        if ((++sp & 255u) == 0u) { if (xb_ld(&bar[XB_TMO])) break; if (sp > XB_SPIN_CAP) { atomicAdd(&bar[XB_TMO], 1u); break; } }
    }
    nloc = mine > 0u ? mine : 1u; nx = cnt > 0u ? cnt : 1u;
}

__device__ __forceinline__ void xcd_barrier(const XcdBarrier& b) {
    asm volatile("s_waitcnt vmcnt(0)" ::: "memory");
    __syncthreads();
    if (threadIdx.x == 0) {
        unsigned* bar = b.bar;
        __builtin_amdgcn_s_waitcnt(0);
        unsigned nloc = b.st[0], nx = b.st[1];
        if (nloc == 0u) { xcd_barrier_complete(bar, b.x, nloc, nx); b.st[0] = nloc; b.st[1] = nx; }
        const unsigned old = xb_add(&bar[XB_XSUB(b.x)], 1u);
        const unsigned gen = old / nloc;
        if (old + 1u == (gen + 1u) * nloc) {
            __builtin_amdgcn_fence(__ATOMIC_RELEASE, "agent");
            asm volatile("s_waitcnt vmcnt(0)" ::: "memory");
            const unsigned og = xb_add(&bar[XB_TOP], 1u);
            const unsigned tg = og / nx;
            if (og + 1u == (tg + 1u) * nx) xb_add(&bar[XB_TOPGEN], 1u);
            else XB_SPIN(xb_ld(&bar[XB_TOPGEN]) == tg, bar);
            __builtin_amdgcn_fence(__ATOMIC_ACQUIRE, "agent");
            xb_add(&bar[XB_XGEN(b.x)], 1u);
            asm volatile("s_waitcnt vmcnt(0)" ::: "memory");
        } else {
            XB_SPIN(xb_ld(&bar[XB_XGEN(b.x)]) == gen, bar);
            __builtin_amdgcn_fence(__ATOMIC_ACQUIRE, "agent");
            asm volatile("s_waitcnt vmcnt(0)" ::: "memory");
        }
    }
    __syncthreads();
}

namespace pg8 {
__device__ __forceinline__ unsigned cvt_pk_bf16(float lo, float hi) { unsigned r; asm volatile("v_cvt_pk_bf16_f32 %0, %1, %2" : "=v"(r) : "v"(lo), "v"(hi)); return r; }
__device__ __forceinline__ float bflo(unsigned w) { return __uint_as_float(w << 16); }
__device__ __forceinline__ float bfhi(unsigned w) { return __uint_as_float(w & 0xffff0000u); }
__device__ __forceinline__ float fast_sigmoid(float x) { return __builtin_amdgcn_rcpf(1.0f + __builtin_amdgcn_exp2f(-1.4426950408889634f * x)); }

struct EpiSwiglu {
    static constexpr bool PERM = true, AFTER_DRAIN = false;
    bf16_t* H; int ldh;
    __device__ __forceinline__ void operator()(const f32x4 (&acc)[2][2][4][2], const Unit& u, int wr, int wc, int fr, int fq) const {
        const int row0 = u.pm * BM + wr * 64 + fr, col0 = u.pn * HALF + wc * 32 + 8 * fq;
#pragma unroll
        for (int ai = 0; ai < 2; ++ai)
#pragma unroll
            for (int m = 0; m < 4; ++m) { bf16_t* rowp = H + (size_t)(row0 + ai * HALF + m * 16) * ldh + col0;
                float h[8];
#pragma unroll
                for (int n = 0; n < 2; ++n)
#pragma unroll
                    for (int j = 0; j < 4; ++j) { const float a = acc[ai][0][m][n][j], b = acc[ai][1][m][n][j]; h[n * 4 + j] = a * fast_sigmoid(a) * b; }
                u32x4 w; w.x = cvt_pk_bf16(h[0], h[1]); w.y = cvt_pk_bf16(h[2], h[3]); w.z = cvt_pk_bf16(h[4], h[5]); w.w = cvt_pk_bf16(h[6], h[7]);
                *(u32x4*)rowp = w; }
    }
};
struct EpiRes {
    static constexpr bool PERM = false, AFTER_DRAIN = false;
    const float* base; float* out; int ld; float s;
    __device__ __forceinline__ void operator()(const f32x4 (&acc)[2][2][4][2], const Unit& u, int wr, int wc, int fr, int fq) const {
        const int row0 = u.pm * BM + wr * 64 + fr, col0 = u.pn * BM + wc * 32 + 4 * fq;
#pragma unroll
        for (int ai = 0; ai < 2; ++ai)
#pragma unroll
            for (int m = 0; m < 4; ++m) { const size_t off = (size_t)(row0 + ai * HALF + m * 16) * ld + col0;
#pragma unroll
                for (int bj = 0; bj < 2; ++bj)
#pragma unroll
                    for (int n = 0; n < 2; ++n) { const f32x4 b = *(const f32x4*)(base + off + bj * HALF + n * 16); *(f32x4*)(out + off + bj * HALF + n * 16) = b + acc[ai][bj][m][n] * s; } }
    }
};
struct EpiCols {
    static constexpr bool PERM = true, AFTER_DRAIN = false;
    bf16_t* O; int ldc; int sig_from;
    __device__ __forceinline__ void operator()(const f32x4 (&acc)[2][2][4][2], const Unit& u, int wr, int wc, int fr, int fq) const {
        const int row0 = u.pm * BM + wr * 64 + fr, col0 = u.pn * BM + wc * 32 + 8 * fq; const bool sg = u.pn >= sig_from;
#pragma unroll
        for (int ai = 0; ai < 2; ++ai)
#pragma unroll
            for (int m = 0; m < 4; ++m) { bf16_t* rowp = O + (size_t)(row0 + ai * HALF + m * 16) * ldc + col0;
#pragma unroll
                for (int bj = 0; bj < 2; ++bj) { f32x4 v0 = acc[ai][bj][m][0], v1 = acc[ai][bj][m][1];
                    if (sg) {
#pragma unroll
                        for (int j = 0; j < 4; ++j) { v0[j] = fast_sigmoid(v0[j]); v1[j] = fast_sigmoid(v1[j]); } }
                    u32x4 w; w.x = cvt_pk_bf16(v0[0], v0[1]); w.y = cvt_pk_bf16(v0[2], v0[3]); w.z = cvt_pk_bf16(v1[0], v1[1]); w.w = cvt_pk_bf16(v1[2], v1[3]);
                    *(u32x4*)(rowp + bj * HALF) = w; } }
    }
};
template <int MODE> struct EpiProj {
    static constexpr bool PERM = true, AFTER_DRAIN = false;
    const bf16_t* G; int ldg; float* ZF; bf16_t* Z; int ld;
    __device__ __forceinline__ void operator()(const f32x4 (&acc)[2][2][4][2], const Unit& u, int wr, int wc, int fr, int fq) const {
        const int row0 = u.pm * BM + wr * 64 + fr, col0 = u.pn * BM + wc * 32 + 8 * fq;
#pragma unroll
        for (int ai = 0; ai < 2; ++ai)
#pragma unroll
            for (int m = 0; m < 4; ++m) { const int row = row0 + ai * HALF + m * 16;
#pragma unroll
                for (int bj = 0; bj < 2; ++bj) { const int col = col0 + bj * HALF;
                    const u32x4 gw = *(const u32x4*)(G + (size_t)row * ldg + col);
                    f32x4 g0 = {bflo(gw.x), bfhi(gw.x), bflo(gw.y), bfhi(gw.y)}, g1 = {bflo(gw.z), bfhi(gw.z), bflo(gw.w), bfhi(gw.w)};
                    f32x4 v0 = acc[ai][bj][m][0] * g0, v1 = acc[ai][bj][m][1] * g1;
                    float* zp = ZF + (size_t)row * ld + col;
                    if (MODE >= 1) { v0 += *(const f32x4*)zp; v1 += *(const f32x4*)(zp + 4); }
                    if (MODE <= 1) { *(f32x4*)zp = v0; *(f32x4*)(zp + 4) = v1; }
                    else { u32x4 w; w.x = cvt_pk_bf16(v0[0], v0[1]); w.y = cvt_pk_bf16(v0[2], v0[3]); w.z = cvt_pk_bf16(v1[0], v1[1]); w.w = cvt_pk_bf16(v1[2], v1[3]);
                        *(u32x4*)(Z + (size_t)row * ld + col) = w; } } }
    }
};
}

constexpr int NWAVES = 8;
constexpr int DM = 2048, NB = 4, SEQ = 2048, DEPTH = 4, MTOK = NB * SEQ, DFF = 5632;
constexpr int NCOLS = 11520;
constexpr int C_QA = 0, C_KA = 768, C_VA = 1536, C_XB = 2304, C_QC = 2816, C_KCMP = 3584, C_VCMP = 3840, C_KSLC = 4096, C_VSLC = 4352, C_KWIN = 4608, C_VWIN = 4864,
              C_GM = 5120  , C_GC = 11264  ;
constexpr int SIG_TILE = C_GM / 256;
constexpr int NBR = 1536;
constexpr float EPS = 1e-6f;
constexpr int NPH_LAYER = 13, NPHASES = 1 + DEPTH * NPH_LAYER;

constexpr size_t MiB = 1u << 20;
constexpr size_t WS_CTL = 0, CTL_ZERO_BYTES = 1 * MiB;
constexpr size_t WS_W = 2 * MiB, W_LAYER = 194 * MiB;
constexpr size_t WO_WI1 = 0, WO_WO1 = 44 * MiB, WO_WIN = 66 * MiB, WO_PROJ = 111 * MiB, WO_WOUT = 117 * MiB, WO_WI2 = 125 * MiB, WO_WO2 = 169 * MiB,
                 WO_C1K = 191 * MiB, WO_C1V = 192 * MiB, WO_C2K = 193 * MiB, WO_C2V = 193 * MiB + 32768, WO_POOL = 193 * MiB + 65536, WO_PEB = 193 * MiB + 262144;
constexpr size_t WS_XN = 780 * MiB, WS_H = 812 * MiB, WS_COLS = 900 * MiB, WS_BR = 1080 * MiB, WS_ZF = 1104 * MiB, WS_Z = 1168 * MiB, WS_OG = 1200 * MiB, WS_LSE = 1224 * MiB,
                 WS_OC = 1225 * MiB, WS_OW = 1249 * MiB, WS_SEL = 1273 * MiB, WS_KC = 1274 * MiB, WS_VC = 1274 * MiB + 512 * 1024, WS_END = 1276 * MiB;
static_assert(WS_W + DEPTH * W_LAYER <= WS_XN, "weights");
static_assert(WS_H + (size_t)MTOK * DFF * 2 <= WS_COLS && WS_COLS + (size_t)MTOK * NCOLS * 2 <= WS_BR && WS_BR + (size_t)MTOK * NBR * 2 <= WS_ZF, "ws map");
constexpr int CW_BAR = 4096;

constexpr int RING_OFF = 0, RING_BYTES = 131072;
constexpr int LDSCTL_OFF = RING_BYTES, MISC_OFF = LDSCTL_OFF + 320;
constexpr int LDS_BYTES = 147456;

__device__ __forceinline__ float bf2f(bf16 h) { return __uint_as_float((unsigned)h << 16); }
__device__ __forceinline__ float wave_sum(float v) {
#pragma unroll
    for (int o = 1; o < 64; o <<= 1) v += __shfl_xor(v, o);
    return v;
}
__device__ __forceinline__ float wave_max(float v) {
#pragma unroll
    for (int o = 1; o < 64; o <<= 1) v = fmaxf(v, __shfl_xor(v, o));
    return v;
}
__device__ __forceinline__ void load8(const bf16* p, float (&f)[8]) {
    const v4u w = *(const v4u*)p;
    f[0] = pg8::bflo(w.x); f[1] = pg8::bfhi(w.x); f[2] = pg8::bflo(w.y); f[3] = pg8::bfhi(w.y); f[4] = pg8::bflo(w.z); f[5] = pg8::bfhi(w.z); f[6] = pg8::bflo(w.w); f[7] = pg8::bfhi(w.w);
}
__device__ __forceinline__ float gelu_tanh(float x) {
    const float y = 0.7978845608028654f * (x + 0.044715f * x * x * x);
    const float t = 1.0f - 2.0f / (1.0f + __expf(2.0f * y));
    return 0.5f * x * (1.0f + t);
}

struct Frame {
    LAS unsigned char* lds;
    volatile LAS unsigned* MISC;
    gu32* ctl;
    volatile LAS unsigned long long* tab;
    int tid, lane, wave, vcu, G, bx, gw, NGW;
};
__device__ __forceinline__ Frame make_frame(LAS unsigned char* lds, unsigned char* ws_ctl) {
    Frame F; int tid = (int)threadIdx.x, G = (int)gridDim.x, bx = (int)blockIdx.x;
    asm volatile("" : "+v"(tid)); asm volatile("" : "+s"(G), "+s"(bx));
    F.lds = lds; F.MISC = (volatile LAS unsigned*)(lds + MISC_OFF); F.tab = (volatile LAS unsigned long long*)(lds + LDSCTL_OFF);
    F.tid = tid; F.lane = tid & 63; F.wave = __builtin_amdgcn_readfirstlane(tid >> 6);
    F.G = G; F.bx = bx; F.vcu = (G % 8 == 0) ? (bx % 8) * (G / 8) + bx / 8 : bx;
    F.gw = F.vcu * NWAVES + F.wave; F.NGW = G * NWAVES; F.ctl = (gu32*)ws_ctl;
    return F;
}
__device__ __forceinline__ unsigned long long tab_get(const Frame& F, int i) {
    const unsigned long long v = F.tab[i];
    const unsigned lo = __builtin_amdgcn_readfirstlane((unsigned)v), hi = __builtin_amdgcn_readfirstlane((unsigned)(v >> 32));
    return ((unsigned long long)hi << 32) | lo;
}
__device__ __forceinline__ const float* in_ptr(const Frame& F, int i) { return (const float*)tab_get(F, i); }
__device__ __forceinline__ float* out_ptr(const Frame& F) { return (float*)tab_get(F, 22); }
__device__ __forceinline__ unsigned char* ws_ptr(const Frame& F) { return (unsigned char*)tab_get(F, 23); }

__device__ __forceinline__ void tr_item(const float* W, int ldn, int c0, int nv, int k0, bf16* WT, size_t r0, int ldk, int kofs, LAS float* scr, int lane) {
#pragma unroll 8
    for (int i = 0; i < 32; ++i) { const int kk = 2 * i + (lane >> 5), n = lane & 31; scr[kk * 33 + n] = (n < nv) ? W[(size_t)(k0 + kk) * ldn + c0 + n] : 0.f; }
    LDS_WAIT(); asm volatile("" ::: "memory");
    const int c = lane & 7;
#pragma unroll
    for (int j = 0; j < 4; ++j) { const int n = (lane >> 3) + 8 * j; const LAS float* s = scr + (8 * c) * 33 + n;
        v4u o; o.x = pk2(s[0 * 33], s[1 * 33]); o.y = pk2(s[2 * 33], s[3 * 33]); o.z = pk2(s[4 * 33], s[5 * 33]); o.w = pk2(s[6 * 33], s[7 * 33]);
        *(GAS v4u*)(WT + (r0 + n) * (size_t)ldk + kofs + k0 + 8 * c) = o; }
    LDS_WAIT(); asm volatile("" ::: "memory");
}

constexpr int I_WI = 352 * 32, I_WO = 64 * 88, I_WIN = 360 * 32, I_PA = 64 * 4, I_PB = 64 * 8, I_PC = 64 * 12, I_WOUT = 64 * 32, I_C1 = 4 * 64, I_C2 = 4 * 2, I_POOL = 4 * 8;
constexpr int I_LAYER = 2 * I_WI + 2 * I_WO + I_WIN + I_PA + I_PB + I_PC + I_WOUT + 2 * I_C1 + 2 * I_C2 + I_POOL;

struct Args { const float* in[22]; float* out; unsigned char* ws; int ph_lo, ph_hi; };

__device__ __forceinline__ void rmsnorm_rows_bf16(const Frame& F, const float* src, const float* gain, bf16* dst) {
    for (int m = F.gw; m < MTOK; m += F.NGW) {
        const GAS f32x4* xr = (const GAS f32x4*)(src + (size_t)m * DM) + F.lane;
        f32x4 v[8]; float s = 0.f;
#pragma unroll
        for (int j = 0; j < 8; ++j) { v[j] = xr[64 * j]; s += (v[j].x * v[j].x + v[j].y * v[j].y) + (v[j].z * v[j].z + v[j].w * v[j].w); }
        const float r = 1.0f / sqrtf(wave_sum(s) * (1.0f / DM) + EPS);
        GAS unsigned long long* o8 = (GAS unsigned long long*)(dst + (size_t)m * DM) + F.lane;
#pragma unroll
        for (int j = 0; j < 8; ++j) { const f32x4 g = ((const GAS f32x4*)gain)[F.lane + 64 * j];
            o8[64 * j] = (unsigned long long)pk2(v[j].x * r * g.x, v[j].y * r * g.y) | ((unsigned long long)pk2(v[j].z * r * g.z, v[j].w * r * g.w) << 32); }
    }
}
__device__ __forceinline__ void rmsnorm_rows_f32(const Frame& F, const float* src, const float* gain, float* dst) {
    for (int m = F.gw; m < MTOK; m += F.NGW) {
        const GAS f32x4* xr = (const GAS f32x4*)(src + (size_t)m * DM) + F.lane;
        f32x4 v[8]; float s = 0.f;
#pragma unroll
        for (int j = 0; j < 8; ++j) { v[j] = xr[64 * j]; s += (v[j].x * v[j].x + v[j].y * v[j].y) + (v[j].z * v[j].z + v[j].w * v[j].w); }
        const float r = 1.0f / sqrtf(wave_sum(s) * (1.0f / DM) + EPS);
        GAS f32x4* o = (GAS f32x4*)(dst + (size_t)m * DM) + F.lane;
#pragma unroll
        for (int j = 0; j < 8; ++j) { const f32x4 g = ((const GAS f32x4*)gain)[F.lane + 64 * j]; o[64 * j] = v[j] * r * g; }
    }
}

template <int DH> struct NAcc {
    static constexpr int LPK = DH / 8, KPW = 64 / LPK;
    float q[8], o[8], m, l; int slot, sub;
    __device__ __forceinline__ void init(const bf16* qvec, float scale, int lane) {
        slot = lane / LPK; sub = lane % LPK; load8(qvec + sub * 8, q);
#pragma unroll
        for (int e = 0; e < 8; ++e) { q[e] *= scale; o[e] = 0.f; }
        m = -1e30f; l = 0.f;
    }
    __device__ __forceinline__ void step(const bf16* krow, const bf16* vrow, bool valid) {
        float s = 0.f; float kv[8];
        if (valid) { load8(krow + sub * 8, kv);
#pragma unroll
            for (int e = 0; e < 8; ++e) s += q[e] * kv[e]; }
#pragma unroll
        for (int off = 1; off < LPK; off <<= 1) s += __shfl_xor(s, off);
        if (valid) { load8(vrow + sub * 8, kv); const float mn = fmaxf(m, s); const float corr = __expf(m - mn), p = __expf(s - mn); l = l * corr + p;
#pragma unroll
            for (int e = 0; e < 8; ++e) o[e] = o[e] * corr + p * kv[e];
            m = mn; }
    }
    __device__ __forceinline__ void finish() {
        float mall = m;
#pragma unroll
        for (int off = LPK; off < 64; off <<= 1) mall = fmaxf(mall, __shfl_xor(mall, off));
        const float f = __expf(m - mall); l *= f;
#pragma unroll
        for (int e = 0; e < 8; ++e) o[e] *= f;
#pragma unroll
        for (int off = LPK; off < 64; off <<= 1) { l += __shfl_xor(l, off);
#pragma unroll
            for (int e = 0; e < 8; ++e) o[e] += __shfl_xor(o[e], off); }
        m = mall;
    }
};

__device__ __forceinline__ void mix_phase_a(const Frame& F, int l) {
    unsigned char* ws = ws_ptr(F);
    const bf16* COLS = (const bf16*)(ws + WS_COLS);
    const int lane = F.lane;
    for (int task = F.gw; task < 2 * 8 * 32; task += F.NGW) {
        const int kv = task & 1, cg = (task >> 1) & 31, bg = task >> 6, b = bg >> 1, g = bg & 1;
        const float* w1 = in_ptr(F, kv ? 12 : 9) + (size_t)l * 4096 * 128; const float* pe = in_ptr(F, kv ? 11 : 8) + (size_t)l * 4096; const float* w2 = in_ptr(F, kv ? 13 : 10) + (size_t)l * 16384;
        const int col0 = (kv ? C_VCMP : C_KCMP) + g * 128;
        float h0[4], h1[4];
#pragma unroll
        for (int ci = 0; ci < 4; ++ci) { h0[ci] = 0.f; h1[ci] = 0.f; }
        for (int k0 = 0; k0 < 4096; k0 += 64) {
            const int j = k0 >> 7, d0 = k0 & 127; const float pv = pe[k0 + lane]; float zl[4];
#pragma unroll
            for (int ci = 0; ci < 4; ++ci) { int c = cg * 4 + ci; c = c > 126 ? 126 : c; zl[ci] = bf2f(COLS[(size_t)(b * SEQ + 16 * c + j) * NCOLS + col0 + d0 + lane]) + pv; }
            for (int i = 0; i < 64; ++i) { const float wa = w1[(size_t)(k0 + i) * 128 + lane], wb = w1[(size_t)(k0 + i) * 128 + 64 + lane];
#pragma unroll
                for (int ci = 0; ci < 4; ++ci) { const float z = __shfl(zl[ci], i); h0[ci] += z * wa; h1[ci] += z * wb; } }
        }
        float o0[4], o1[4];
#pragma unroll
        for (int ci = 0; ci < 4; ++ci) { h0[ci] = gelu_tanh(h0[ci]); h1[ci] = gelu_tanh(h1[ci]); o0[ci] = 0.f; o1[ci] = 0.f; }
        for (int i = 0; i < 64; ++i) { const float wa = w2[i * 128 + lane], wb = w2[i * 128 + 64 + lane], wc = w2[(64 + i) * 128 + lane], wd = w2[(64 + i) * 128 + 64 + lane];
#pragma unroll
            for (int ci = 0; ci < 4; ++ci) { const float x0 = __shfl(h0[ci], i), x1 = __shfl(h1[ci], i); o0[ci] += x0 * wa + x1 * wc; o1[ci] += x0 * wb + x1 * wd; } }
        bf16* dst = (bf16*)(ws + (kv ? WS_VC : WS_KC));
#pragma unroll
        for (int ci = 0; ci < 4; ++ci) { const int c = cg * 4 + ci; if (c < 127) { dst[(size_t)(bg * 128 + c) * 128 + lane] = (bf16)f2bf(o0[ci]); dst[(size_t)(bg * 128 + c) * 128 + 64 + lane] = (bf16)f2bf(o1[ci]); } }
    }
    float* OG = (float*)(ws + WS_OG); float* LSE = (float*)(ws + WS_LSE);
    for (int task = F.gw; task < MTOK * 12; task += F.NGW) {
        const int row = task / 12, gh = task - row * 12, b = row >> 11, s = row & 2047, gi = gh >> 2, h = gh & 3, dil = 1 << (2 * gi);
        NAcc<64> A; A.init(COLS + (size_t)row * NCOLS + C_QA + gh * 64, 0.125f, lane);
        int nj = s / dil; nj = (nj > 128 ? 128 : nj) + 1;
        for (int j0 = 0; j0 < nj; j0 += 8) { const int j = j0 + A.slot; const bool valid = j < nj; const size_t kr = (size_t)(b * SEQ + s - (valid ? j : 0) * dil) * NCOLS + gh * 64;
            A.step(COLS + kr + C_KA, COLS + kr + C_VA, valid); }
        A.finish();
        const float inv = 1.0f / A.l;
        if (A.slot == 0) { float* op = OG + ((size_t)gi * MTOK + row) * 256 + h * 64 + A.sub * 8;
            *(f32x4*)op = (f32x4){A.o[0] * inv, A.o[1] * inv, A.o[2] * inv, A.o[3] * inv}; *(f32x4*)(op + 4) = (f32x4){A.o[4] * inv, A.o[5] * inv, A.o[6] * inv, A.o[7] * inv}; }
        if (lane == 0) LSE[((size_t)gi * MTOK + row) * 4 + h] = A.m + __logf(A.l);
    }
    float* OW = (float*)(ws + WS_OW);
    for (int task = F.gw; task < MTOK * 6; task += F.NGW) {
        const int row = task / 6, gn = task - row * 6, b = row >> 11, s = row & 2047, g = gn / 3;
        NAcc<128> A; A.init(COLS + (size_t)row * NCOLS + C_QC + gn * 128, 0.08838834764831845f, lane);
        const int k0 = s > 511 ? s - 511 : 0;
        for (int kp = k0; kp <= s; kp += 4) { const int kpos = kp + A.slot; const bool valid = kpos <= s; const size_t kr = (size_t)(b * SEQ + (valid ? kpos : s)) * NCOLS + g * 128;
            A.step(COLS + kr + C_KWIN, COLS + kr + C_VWIN, valid); }
        A.finish();
        const float gate = bf2f(COLS[(size_t)row * NCOLS + C_GC + gn * 3 + 2]) / A.l;
        if (A.slot == 0) { float* op = OW + (size_t)row * 768 + gn * 128 + A.sub * 8;
            *(f32x4*)op = (f32x4){A.o[0] * gate, A.o[1] * gate, A.o[2] * gate, A.o[3] * gate}; *(f32x4*)(op + 4) = (f32x4){A.o[4] * gate, A.o[5] * gate, A.o[6] * gate, A.o[7] * gate}; }
    }
    bf16* BR = (bf16*)(ws + WS_BR);
    const float* pw_l = in_ptr(F, 6) + (size_t)l * 4 * 16384; const float* psc = in_ptr(F, 7) + (size_t)l * 512;
    for (int task = F.gw; task < MTOK * 4; task += F.NGW) {
        const int row = task >> 2, gi = task & 3, b = row >> 11, s = row & 2047, w = 2 << gi;
        const int lo = s + 1 - w > 0 ? s + 1 - w : 0; const float rc = 1.0f / (float)(s + 1 - lo);
        float p0 = 0.f, p1 = 0.f;
        for (int t = lo; t <= s; ++t) { const bf16* xr = COLS + (size_t)(b * SEQ + t) * NCOLS + C_XB + gi * 128; p0 += bf2f(xr[lane]); p1 += bf2f(xr[64 + lane]); }
        { const bf16* xr = COLS + (size_t)row * NCOLS + C_XB + gi * 128; p0 = p0 * rc - bf2f(xr[lane]); p1 = p1 * rc - bf2f(xr[64 + lane]); }
        const float* pw = pw_l + gi * 16384; float z0 = 0.f, z1 = 0.f;
        for (int i = 0; i < 64; ++i) { const float x0 = __shfl(p0, i), x1 = __shfl(p1, i);
            z0 += x0 * pw[i * 128 + lane] + x1 * pw[(64 + i) * 128 + lane]; z1 += x0 * pw[i * 128 + 64 + lane] + x1 * pw[(64 + i) * 128 + 64 + lane]; }
        BR[(size_t)row * NBR + 256 + gi * 128 + lane] = (bf16)f2bf(z0 * psc[gi * 128 + lane]); BR[(size_t)row * NBR + 256 + gi * 128 + 64 + lane] = (bf16)f2bf(z1 * psc[gi * 128 + 64 + lane]);
    }
}

__device__ __forceinline__ void mix_phase_b(const Frame& F) {
    unsigned char* ws = ws_ptr(F);
    const bf16* COLS = (const bf16*)(ws + WS_COLS); const bf16* KC = (const bf16*)(ws + WS_KC); const bf16* VC = (const bf16*)(ws + WS_VC);
    float* OC = (float*)(ws + WS_OC); unsigned* SEL = (unsigned*)(ws + WS_SEL);
    LAS float* sc = (LAS float*)(F.lds + RING_OFF + F.wave * 1024);
    LAS float* ps = sc + 128;
    const int lane = F.lane, slot = lane >> 4, sub = lane & 15;
    for (int task = F.gw; task < MTOK * 2; task += F.NGW) {
        const int row = task >> 1, g = task & 1, b = row >> 11, s = row & 2047, bg = b * 2 + g;
        int nvalid = s >= 31 ? (s - 31) / 16 + 1 : 0; nvalid = nvalid > 127 ? 127 : nvalid;
        float psum0 = 0.f, psum1 = 0.f;
        for (int n = 0; n < 3; ++n) {
            const int gn = g * 3 + n; float q[8]; load8(COLS + (size_t)row * NCOLS + C_QC + gn * 128 + sub * 8, q);
            for (int c0 = 0; c0 < nvalid; c0 += 4) { const int c = c0 + slot; const bool valid = c < nvalid; float d = 0.f;
                if (valid) { float kv[8]; load8(KC + (size_t)(bg * 128 + c) * 128 + sub * 8, kv);
#pragma unroll
                    for (int e = 0; e < 8; ++e) d += q[e] * kv[e]; }
                d += __shfl_xor(d, 1); d += __shfl_xor(d, 2); d += __shfl_xor(d, 4); d += __shfl_xor(d, 8);
                if (valid && sub == 0) sc[c] = d * 0.08838834764831845f; }
            LDS_WAIT(); asm volatile("" ::: "memory");
            const float s0 = lane < nvalid ? sc[lane] : -1e30f, s1 = lane + 64 < nvalid ? sc[lane + 64] : -1e30f;
            const float mx = wave_max(fmaxf(s0, s1));
            const float e0 = lane < nvalid ? __expf(s0 - mx) : 0.f, e1 = lane + 64 < nvalid ? __expf(s1 - mx) : 0.f;
            const float sum = wave_sum(e0 + e1); const float inv = nvalid > 0 ? 1.0f / sum : 0.f;
            const float p0 = e0 * inv, p1 = e1 * inv; psum0 += p0; psum1 += p1;
            LDS_WAIT(); asm volatile("" ::: "memory");
            sc[lane] = p0; sc[lane + 64] = p1;
            LDS_WAIT(); asm volatile("" ::: "memory");
            float o0 = 0.f, o1 = 0.f;
            for (int c = 0; c < nvalid; ++c) { const float p = sc[c]; const unsigned v2 = *(const unsigned*)(VC + (size_t)(bg * 128 + c) * 128 + 2 * lane); o0 += p * pg8::bflo(v2); o1 += p * pg8::bfhi(v2); }
            const float gate = bf2f(COLS[(size_t)row * NCOLS + C_GC + gn * 3 + 0]);
            typedef float f32x2 __attribute__((ext_vector_type(2)));
            *(f32x2*)(OC + (size_t)row * 768 + gn * 128 + 2 * lane) = (f32x2){gate * o0, gate * o1};
            LDS_WAIT(); asm volatile("" ::: "memory");
        }
        ps[lane] = psum0; ps[lane + 64] = psum1;
        LDS_WAIT(); asm volatile("" ::: "memory");
        const int j = lane & 31, tb = s >> 6; float imp = 0.f;
#pragma unroll
        for (int cc = -1; cc <= 3; ++cc) { const int c = 4 * j + cc; if (c >= 0 && c <= 126) imp += ps[c]; }
        const bool forced = (j == 0) || (j == tb) || (j == tb - 1);
        const float score = j > tb ? -1.0f : imp + (forced ? 100.0f : 0.0f);
        int rank = 0;
        for (int i = 0; i < 32; ++i) { const float si = __shfl(score, i); rank += (si > score || (si == score && i < j)) ? 1 : 0; }
        const unsigned long long bal = __ballot(lane < 32 && rank < 8);
        if (lane == 0) SEL[row * 2 + g] = (unsigned)bal;
        LDS_WAIT(); asm volatile("" ::: "memory");
    }
}

__device__ __forceinline__ void mix_phase_c(const Frame& F) {
    unsigned char* ws = ws_ptr(F);
    const bf16* COLS = (const bf16*)(ws + WS_COLS); const float* OC = (const float*)(ws + WS_OC); const float* OW = (const float*)(ws + WS_OW);
    const unsigned* SEL = (const unsigned*)(ws + WS_SEL); bf16* BR = (bf16*)(ws + WS_BR);
    const int lane = F.lane;
    for (int task = F.gw; task < MTOK * 6; task += F.NGW) {
        const int row = task / 6, gn = task - row * 6, b = row >> 11, s = row & 2047, g = gn / 3, tb = s >> 6;
        const unsigned mask = __hip_atomic_load((unsigned*)SEL + row * 2 + g, __ATOMIC_RELAXED, __HIP_MEMORY_SCOPE_AGENT);
        NAcc<128> A; A.init(COLS + (size_t)row * NCOLS + C_QC + gn * 128, 0.08838834764831845f, lane);
        for (int j = 0; j <= tb; ++j) { if (!((mask >> j) & 1u)) continue;
            for (int kk = 0; kk < 64; kk += 4) { const int kpos = 64 * j + kk + A.slot; const bool valid = kpos <= s; const size_t kr = (size_t)(b * SEQ + (valid ? kpos : s)) * NCOLS + g * 128;
                A.step(COLS + kr + C_KSLC, COLS + kr + C_VSLC, valid); } }
        A.finish();
        const float gate = bf2f(COLS[(size_t)row * NCOLS + C_GC + gn * 3 + 1]) / A.l;
        if (A.slot == 0) { const size_t off = (size_t)row * 768 + gn * 128 + A.sub * 8;
            const f32x4 c0 = *(const f32x4*)(OC + off), c1 = *(const f32x4*)(OC + off + 4), w0 = *(const f32x4*)(OW + off), w1 = *(const f32x4*)(OW + off + 4);
            v4u o; o.x = pk2(c0.x + w0.x + gate * A.o[0], c0.y + w0.y + gate * A.o[1]); o.y = pk2(c0.z + w0.z + gate * A.o[2], c0.w + w0.w + gate * A.o[3]);
            o.z = pk2(c1.x + w1.x + gate * A.o[4], c1.y + w1.y + gate * A.o[5]); o.w = pk2(c1.z + w1.z + gate * A.o[6], c1.w + w1.w + gate * A.o[7]);
            *(v4u*)(BR + (size_t)row * NBR + 768 + gn * 128 + A.sub * 8) = o; }
    }
    const float* OG = (const float*)(ws + WS_OG); const float* LSE = (const float*)(ws + WS_LSE);
    for (int row = F.gw; row < MTOK; row += F.NGW) {
        const int h = lane >> 4;
        const float l0 = LSE[((size_t)0 * MTOK + row) * 4 + h], l1 = LSE[((size_t)1 * MTOK + row) * 4 + h], l2 = LSE[((size_t)2 * MTOK + row) * 4 + h];
        const float mx = fmaxf(l0, fmaxf(l1, l2)); float w0 = __expf(l0 - mx), w1 = __expf(l1 - mx), w2 = __expf(l2 - mx); const float inv = 1.0f / (w0 + w1 + w2); w0 *= inv; w1 *= inv; w2 *= inv;
        const f32x4 a0 = *(const f32x4*)(OG + ((size_t)0 * MTOK + row) * 256 + lane * 4), a1 = *(const f32x4*)(OG + ((size_t)1 * MTOK + row) * 256 + lane * 4), a2 = *(const f32x4*)(OG + ((size_t)2 * MTOK + row) * 256 + lane * 4);
        const f32x4 o = a0 * w0 + a1 * w1 + a2 * w2;
        *(unsigned long long*)(BR + (size_t)row * NBR + lane * 4) = (unsigned long long)pk2(o.x, o.y) | ((unsigned long long)pk2(o.z, o.w) << 32);
    }
}

#define PH_BEGIN if (ph >= lo && ph < hi) { const Frame F = make_frame(ldsp, nullptr);
#define PH_END if (ph + 1 < hi) xcd_barrier(bar); } ++ph;
#define WSP(off) (ws_ptr(F) + (off))
template <int l> __device__ __forceinline__ void layer_phases(LAS unsigned char* const ldsp, const int lo, const int hi, int& ph, const XcdBarrier& bar) {
        PH_BEGIN
        { unsigned char* ws = ws_ptr(F); unsigned char* wl = ws + WS_W + (size_t)l * W_LAYER;
          pg8::Gemm g{(const bf16*)(ws + WS_XN), (const bf16*)(wl + WO_WI1), MTOK, 2 * DFF, DM, DM, DM}; pg8::StaticOrder S; S.init(MTOK, 2 * DFF, F.G, F.bx);
          pg8::EpiSwiglu E{(bf16*)(ws + WS_H), DFF}; pg8::gemm_phase<pg8::EpiSwiglu, pg8::StaticOrder, true, true>(F.lds + RING_OFF, g, S, E); }
        PH_END
        PH_BEGIN
        { unsigned char* ws = ws_ptr(F); unsigned char* wl = ws + WS_W + (size_t)l * W_LAYER; float* X = out_ptr(F);
          pg8::Gemm g{(const bf16*)(ws + WS_H), (const bf16*)(wl + WO_WO1), MTOK, DM, DFF, DFF, DFF}; pg8::StaticOrder S; S.init(MTOK, DM, F.G, F.bx);
          pg8::EpiRes E{l == 0 ? in_ptr(F, 0) : X, X, DM, 0.5f}; pg8::gemm_phase<pg8::EpiRes, pg8::StaticOrder, true, true>(F.lds + RING_OFF, g, S, E); }
        PH_END
        PH_BEGIN
        rmsnorm_rows_bf16(F, out_ptr(F), in_ptr(F, 4) + (size_t)l * DM, (bf16*)WSP(WS_XN));
        PH_END
        PH_BEGIN
        { unsigned char* ws = ws_ptr(F); unsigned char* wl = ws + WS_W + (size_t)l * W_LAYER;
          pg8::Gemm g{(const bf16*)(ws + WS_XN), (const bf16*)(wl + WO_WIN), MTOK, NCOLS, DM, DM, DM}; pg8::StaticOrder S; S.init(MTOK, NCOLS, F.G, F.bx);
          pg8::EpiCols E{(bf16*)(ws + WS_COLS), NCOLS, SIG_TILE}; pg8::gemm_phase<pg8::EpiCols, pg8::StaticOrder, true, true>(F.lds + RING_OFF, g, S, E); }
        PH_END
        PH_BEGIN
        mix_phase_a(F, l);
        PH_END
        PH_BEGIN
        mix_phase_b(F);
        PH_END
        PH_BEGIN
        mix_phase_c(F);
        PH_END
        PH_BEGIN
        { unsigned char* ws = ws_ptr(F); unsigned char* wl = ws + WS_W + (size_t)l * W_LAYER;
          const bf16* BR = (const bf16*)(ws + WS_BR); const bf16* PT = (const bf16*)(wl + WO_PROJ); const bf16* GM = (const bf16*)(ws + WS_COLS) + C_GM; float* ZF = (float*)(ws + WS_ZF); bf16* Z = (bf16*)(ws + WS_Z);
          pg8::StaticOrder S; S.init(MTOK, DM, F.G, F.bx);
          { pg8::Gemm g{BR, PT, MTOK, DM, 256, NBR, NBR}; pg8::EpiProj<0> E{GM, NCOLS, ZF, Z, DM}; pg8::gemm_phase<pg8::EpiProj<0>, pg8::StaticOrder, true, true>(F.lds + RING_OFF, g, S, E); }
          { pg8::Gemm g{BR + 256, PT + 256, MTOK, DM, 512, NBR, NBR}; pg8::EpiProj<1> E{GM + 2048, NCOLS, ZF, Z, DM}; pg8::gemm_phase<pg8::EpiProj<1>, pg8::StaticOrder, true, true>(F.lds + RING_OFF, g, S, E); }
          { pg8::Gemm g{BR + 768, PT + 768, MTOK, DM, 768, NBR, NBR}; pg8::EpiProj<2> E{GM + 4096, NCOLS, ZF, Z, DM}; pg8::gemm_phase<pg8::EpiProj<2>, pg8::StaticOrder, true, true>(F.lds + RING_OFF, g, S, E); }
        }
        PH_END
        PH_BEGIN
        { unsigned char* ws = ws_ptr(F); unsigned char* wl = ws + WS_W + (size_t)l * W_LAYER; float* X = out_ptr(F);
          pg8::Gemm g{(const bf16*)(ws + WS_Z), (const bf16*)(wl + WO_WOUT), MTOK, DM, DM, DM, DM}; pg8::StaticOrder S; S.init(MTOK, DM, F.G, F.bx);
          pg8::EpiRes E{X, X, DM, 1.0f}; pg8::gemm_phase<pg8::EpiRes, pg8::StaticOrder, true, true>(F.lds + RING_OFF, g, S, E); }
        PH_END
        PH_BEGIN
        rmsnorm_rows_bf16(F, out_ptr(F), in_ptr(F, 18) + (size_t)l * DM, (bf16*)WSP(WS_XN));
        PH_END
        PH_BEGIN
        { unsigned char* ws = ws_ptr(F); unsigned char* wl = ws + WS_W + (size_t)l * W_LAYER;
          pg8::Gemm g{(const bf16*)(ws + WS_XN), (const bf16*)(wl + WO_WI2), MTOK, 2 * DFF, DM, DM, DM}; pg8::StaticOrder S; S.init(MTOK, 2 * DFF, F.G, F.bx);
          pg8::EpiSwiglu E{(bf16*)(ws + WS_H), DFF}; pg8::gemm_phase<pg8::EpiSwiglu, pg8::StaticOrder, true, true>(F.lds + RING_OFF, g, S, E); }
        PH_END
        PH_BEGIN
        { unsigned char* ws = ws_ptr(F); unsigned char* wl = ws + WS_W + (size_t)l * W_LAYER; float* X = out_ptr(F);
          pg8::Gemm g{(const bf16*)(ws + WS_H), (const bf16*)(wl + WO_WO2), MTOK, DM, DFF, DFF, DFF}; pg8::StaticOrder S; S.init(MTOK, DM, F.G, F.bx);
          pg8::EpiRes E{X, X, DM, 0.5f}; pg8::gemm_phase<pg8::EpiRes, pg8::StaticOrder, true, true>(F.lds + RING_OFF, g, S, E); }
        PH_END
        PH_BEGIN
        if (l + 1 < DEPTH) rmsnorm_rows_bf16(F, out_ptr(F), in_ptr(F, 1) + (size_t)(l + 1) * DM, (bf16*)WSP(WS_XN));
        else rmsnorm_rows_f32(F, out_ptr(F), in_ptr(F, 21), out_ptr(F));
        PH_END
}
#undef PH_BEGIN
#undef PH_END
#undef WSP

__global__ void __launch_bounds__(NWAVES * 64, 2) trunk_fwd(Args args) {
    extern __shared__ __attribute__((aligned(16))) unsigned char lds[];
    LAS unsigned char* const ldsp = (LAS unsigned char*)lds;
    {
        const int tid = threadIdx.x;
        for (int u = tid; u < (LDS_BYTES - LDSCTL_OFF) / 4; u += NWAVES * 64) ((LAS unsigned*)(ldsp + LDSCTL_OFF))[u] = 0u;
        __syncthreads();
        if (tid == 0) { volatile LAS unsigned long long* tab = (volatile LAS unsigned long long*)(ldsp + LDSCTL_OFF);
#pragma unroll
            for (int i = 0; i < 22; ++i) tab[i] = (unsigned long long)args.in[i];
            tab[22] = (unsigned long long)args.out; tab[23] = (unsigned long long)args.ws; }
        __syncthreads();
    }
    const int lo = args.ph_lo, hi = args.ph_hi;
    XcdBarrier bar; bar.bar = (unsigned*)(args.ws + WS_CTL) + CW_BAR; bar.x = 0; bar.st = nullptr;
    if (hi - lo > 1) bar = xcd_barrier_post((unsigned*)(args.ws + WS_CTL) + CW_BAR, (volatile LAS unsigned*)(ldsp + MISC_OFF) + 8);
    int ph = 0;
#define PH_BEGIN if (ph >= lo && ph < hi) { const Frame F = make_frame(ldsp, nullptr);
#define PH_END if (ph + 1 < hi) xcd_barrier(bar); } ++ph;
#define WSP(off) (ws_ptr(F) + (off))

    PH_BEGIN
    {
        LAS float* scr = (LAS float*)(F.lds + RING_OFF + F.wave * 16384);
        unsigned char* ws = ws_ptr(F);
        for (int it = F.gw; it < DEPTH * I_LAYER; it += F.NGW) {
            const int l = it / I_LAYER; int r = it - l * I_LAYER;
            unsigned char* wl = ws + WS_W + (size_t)l * W_LAYER;
            const float* W; int ldn, mode = 0, nrb, ldk, kofs = 0; bf16* WT;
            if (r < I_WI) { W = in_ptr(F, 2) + (size_t)l * DM * 2 * DFF; ldn = 2 * DFF; mode = 1; nrb = 352; WT = (bf16*)(wl + WO_WI1); ldk = DM; }
            else if ((r -= I_WI) < I_WO) { W = in_ptr(F, 3) + (size_t)l * DFF * DM; ldn = DM; nrb = 64; WT = (bf16*)(wl + WO_WO1); ldk = DFF; }
            else if ((r -= I_WO) < I_WIN) { W = in_ptr(F, 5) + (size_t)l * DM * 11282; ldn = 11282; mode = 2; nrb = 360; WT = (bf16*)(wl + WO_WIN); ldk = DM; }
            else if ((r -= I_WIN) < I_PA) { W = in_ptr(F, 14) + (size_t)l * 256 * DM; ldn = DM; nrb = 64; WT = (bf16*)(wl + WO_PROJ); ldk = NBR; kofs = 0; }
            else if ((r -= I_PA) < I_PB) { W = in_ptr(F, 15) + (size_t)l * 512 * DM; ldn = DM; nrb = 64; WT = (bf16*)(wl + WO_PROJ); ldk = NBR; kofs = 256; }
            else if ((r -= I_PB) < I_PC) { W = in_ptr(F, 16) + (size_t)l * 768 * DM; ldn = DM; nrb = 64; WT = (bf16*)(wl + WO_PROJ); ldk = NBR; kofs = 768; }
            else if ((r -= I_PC) < I_WOUT) { W = in_ptr(F, 17) + (size_t)l * DM * DM; ldn = DM; nrb = 64; WT = (bf16*)(wl + WO_WOUT); ldk = DM; }
            else if ((r -= I_WOUT) < I_WI) { W = in_ptr(F, 19) + (size_t)l * DM * 2 * DFF; ldn = 2 * DFF; mode = 1; nrb = 352; WT = (bf16*)(wl + WO_WI2); ldk = DM; }
            else if ((r -= I_WI) < I_WO) { W = in_ptr(F, 20) + (size_t)l * DFF * DM; ldn = DM; nrb = 64; WT = (bf16*)(wl + WO_WO2); ldk = DFF; }
            else if ((r -= I_WO) < I_C1) { W = in_ptr(F, 9) + (size_t)l * 4096 * 128; ldn = 128; nrb = 4; WT = (bf16*)(wl + WO_C1K); ldk = 4096; }
            else if ((r -= I_C1) < I_C1) { W = in_ptr(F, 12) + (size_t)l * 4096 * 128; ldn = 128; nrb = 4; WT = (bf16*)(wl + WO_C1V); ldk = 4096; }
            else if ((r -= I_C1) < I_C2) { W = in_ptr(F, 10) + (size_t)l * 16384; ldn = 128; nrb = 4; WT = (bf16*)(wl + WO_C2K); ldk = 128; }
            else if ((r -= I_C2) < I_C2) { W = in_ptr(F, 13) + (size_t)l * 16384; ldn = 128; nrb = 4; WT = (bf16*)(wl + WO_C2V); ldk = 128; }
            else { r -= I_C2; const int gi = r >> 3; r &= 7; W = in_ptr(F, 6) + (size_t)(l * 4 + gi) * 16384; ldn = 128; nrb = 4; WT = (bf16*)(wl + WO_POOL) + gi * 16384; ldk = 128; }
            const int kb = r / nrb, rb = r - kb * nrb; int c0 = 32 * rb, nv = 32;
            if (mode == 1) { const int t = rb >> 3, w = rb & 7; c0 = w < 4 ? t * 128 + w * 32 : DFF + t * 128 + (w - 4) * 32; }
            else if (mode == 2) { const int d0 = 32 * rb; if (d0 < C_GM) c0 = d0; else if (d0 < C_GC) c0 = d0 + 18; else if (d0 == C_GC) { c0 = 5120; nv = 18; } else { c0 = 0; nv = 0; } }
            tr_item(W, ldn, c0, nv, 64 * kb, WT, (size_t)32 * rb, ldk, kofs, scr, F.lane);
        }
        rmsnorm_rows_bf16(F, in_ptr(F, 0), in_ptr(F, 1), (bf16*)(ws + WS_XN));
    }
    PH_END

    layer_phases<0>(ldsp, lo, hi, ph, bar); layer_phases<1>(ldsp, lo, hi, ph, bar); layer_phases<2>(ldsp, lo, hi, ph, bar); layer_phases<3>(ldsp, lo, hi, ph, bar);
#undef PH_BEGIN
#undef PH_END
#undef WSP
}

#ifndef MK_ONE_LAUNCH
#define MK_ONE_LAUNCH 0
#endif
extern "C" void kernel_launch(void* const* d_in, const int* in_sizes, int n_in, void* d_out, int out_size, void* d_ws, size_t ws_size, hipStream_t stream) {
    static int grid = 0;
    if (grid == 0) {
        if (n_in != 22 || in_sizes[0] != MTOK * DM || out_size != MTOK * DM || ws_size < WS_END) { fprintf(stderr, "kernel_launch: unexpected shapes (n_in %d, in0 %d, out %d, ws %zu < %zu)\n", n_in, n_in > 0 ? in_sizes[0] : -1, out_size, ws_size, (size_t)WS_END); grid = -1; return; }
        int dev = 0, cus = 0, per_cu = 0;
        if (hipGetDevice(&dev) != hipSuccess || hipDeviceGetAttribute(&cus, hipDeviceAttributeMultiprocessorCount, dev) != hipSuccess) { grid = -1; return; }
        if (hipFuncSetAttribute((const void*)trunk_fwd, hipFuncAttributeMaxDynamicSharedMemorySize, LDS_BYTES) != hipSuccess) { fprintf(stderr, "kernel_launch: hipFuncSetAttribute failed\n"); grid = -1; return; }
        if (hipOccupancyMaxActiveBlocksPerMultiprocessor(&per_cu, (const void*)trunk_fwd, NWAVES * 64, LDS_BYTES) != hipSuccess || per_cu < 1) fprintf(stderr, "kernel_launch: occupancy query reports %d\n", per_cu);
        (void)hipGetLastError();
        grid = cus;
    }
    if (grid < 0) return;
    if (hipMemsetAsync((char*)d_ws + WS_CTL, 0, CTL_ZERO_BYTES, stream) != hipSuccess) return;
    Args a{};
    for (int i = 0; i < 22; ++i) a.in[i] = (const float*)d_in[i];
    a.out = (float*)d_out; a.ws = (unsigned char*)d_ws;
#if MK_ONE_LAUNCH
    a.ph_lo = 0; a.ph_hi = NPHASES;
    hipLaunchKernelGGL(trunk_fwd, dim3(grid), dim3(NWAVES * 64), LDS_BYTES, stream, a);
#else
    for (int p = 0; p < NPHASES; ++p) { a.ph_lo = p; a.ph_hi = p + 1; hipLaunchKernelGGL(trunk_fwd, dim3(grid), dim3(NWAVES * 64), LDS_BYTES, stream, a); }
#endif
}
```

```cpp
#include <hip/hip_runtime.h>
#include <cstdio>
#include <cstdint>
namespace pg8 {
#define PG8_LAS __attribute__((address_space(3)))
typedef unsigned short bf16_t;
typedef short bf16x8 __attribute__((ext_vector_type(8)));
typedef float f32x4 __attribute__((ext_vector_type(4)));
typedef unsigned u32x4 __attribute__((ext_vector_type(4)));
constexpr int BM = 256, BK = 64, HALF = 128, HTB = HALF * BK * 2  , STAGE_BYTES = 8 * HTB, NXCD = 8, WGM = 8;

__host__ __device__ __forceinline__ int lds_byte(int r, int c) { const int st = (r >> 4) * 2 + (c >> 5), rr = r & 15, cc = c & 31, ob = rr * 64 + cc * 2; return st * 1024 + (ob ^ (((ob >> 9) & 1) << 5)); }
__host__ __device__ __forceinline__ void stage_rc(int b, int& R, int& C) { const int st = b / 1024, sb = b % 1024, swz = sb ^ (((sb >> 9) & 1) << 5); R = (st >> 1) * 16 + swz / 64; C = (st & 1) * 32 + (swz % 64) / 2; }
__host__ __device__ __forceinline__ int perm32(int rho) { const int n = rho >> 4, i = rho & 15; return 8 * (i >> 2) + 4 * n + (i & 3); }

struct Unit { int pm, pn; };
struct Gemm { const bf16_t* A; const bf16_t* Bt; int M, N, K, lda, ldb; };

struct StaticOrder {
    int nM, nN, nwg, G, c;
    __host__ __device__ void init(int M, int N, int G_, int c_) { nM = M / BM; nN = N / BM; nwg = nM * nN; G = G_; c = c_; }
    __host__ __device__ bool next(int i, Unit& u) const {
        const long L = (long)i * G + c; if (L >= nwg) return false;
        int wgid = (int)L; { const int q = nwg / NXCD, r = nwg % NXCD, xcd = wgid % NXCD, off = wgid / NXCD; wgid = (xcd < r ? xcd * (q + 1) : r * (q + 1) + (xcd - r) * q) + off; }
        const int nig = WGM * nN, gid = wgid / nig, fm = gid * WGM, gsz = (nM - fm) < WGM ? (nM - fm) : WGM;
        u.pm = fm + ((wgid % nig) % gsz); u.pn = (wgid % nig) / gsz; return true;
    }
    __device__ __forceinline__ void a_ready(const Unit&) const {}
    __device__ __forceinline__ void done(const Unit&) const {}
};

template <class Epi, class Sched, bool ALIGN_EPI = false, bool SP2 = false>
__device__ __forceinline__ void gemm_phase(PG8_LAS unsigned char* lds, const Gemm g, const Sched& S, const Epi& E) {
    int tid_l = (int)threadIdx.x; asm volatile("" : "+v"(tid_l));
    const int tid = tid_l, wid = __builtin_amdgcn_readfirstlane(tid >> 6), lane = tid & 63, wr = wid >> 2, wc = wid & 3, fr = lane & 15, fq = lane >> 4;
    const int K = g.K, nt = K / BK;
    unsigned voffA[2], voffB[2];
#pragma unroll
    for (int i = 0; i < 2; ++i) { int R, C; stage_rc(tid * 16 + i * 8192, R, C); const int Rb = Epi::PERM ? ((R & ~31) + perm32(R & 31)) : R;
        voffA[i] = (unsigned)(R * g.lda + C) * 2u; voffB[i] = (unsigned)(Rb * g.ldb + C) * 2u; }
    const size_t kstep = (size_t)(BK * 2);
    const size_t hstepA = (size_t)HALF * g.lda * 2, hstepB = (size_t)HALF * g.ldb * 2;
    const size_t tstepA = 2 * hstepA, tstepB = 2 * hstepB;
    const unsigned ldsw = (unsigned)wid * 1024u;
    const int aoff = lds_byte(wr * 64 + fr, fq * 8), boff = lds_byte(wc * 32 + fr, fq * 8);
#define PG8_SA(b, h) (((b) * 2 + (h)) * HTB)
#define PG8_SB(b, h) ((4 + (b) * 2 + (h)) * HTB)
#define PG8_STAGE(bufoff, gbase, voff) do { _Pragma("unroll") for (int _i = 0; _i < 2; ++_i) \
        __builtin_amdgcn_global_load_lds((const unsigned*)((const char*)(gbase) + (voff)[_i]), (PG8_LAS unsigned*)(lds + (bufoff) + ldsw + _i * 8192), 16, 0, 0); } while (0)
#define PG8_LDA(dst, b, h) do { _Pragma("unroll") for (int m = 0; m < 4; ++m) _Pragma("unroll") for (int k = 0; k < 2; ++k) dst[m][k] = *(const PG8_LAS bf16x8*)(lds + PG8_SA(b, h) + aoff + m * 2048 + k * 1024); } while (0)
#define PG8_LDB(dst, b, h) do { _Pragma("unroll") for (int n = 0; n < 2; ++n) _Pragma("unroll") for (int k = 0; k < 2; ++k) dst[n][k] = *(const PG8_LAS bf16x8*)(lds + PG8_SB(b, h) + boff + n * 2048 + k * 1024); } while (0)
#define PG8_MMA(ai, bj, At, Bt) do { __builtin_amdgcn_s_setprio(1); _Pragma("unroll") for (int m = 0; m < 4; ++m) _Pragma("unroll") for (int n = 0; n < 2; ++n) _Pragma("unroll") for (int k = 0; k < 2; ++k) \
        acc[ai][bj][m][n] = __builtin_amdgcn_mfma_f32_16x16x32_bf16(Bt[n][k], At[m][k], acc[ai][bj][m][n], 0, 0, 0); __builtin_amdgcn_s_setprio(0); } while (0)
#define PG8_WAIT_V(n) asm volatile("s_waitcnt vmcnt(" #n ")" ::: "memory")
#define PG8_WAIT_L(n) asm volatile("s_waitcnt lgkmcnt(" #n ")" ::: "memory")
#define PG8_BAR __builtin_amdgcn_s_barrier()
#define PG8_SCHED __builtin_amdgcn_sched_barrier(0)
    Unit cur, nxt; int ui = 0;
    if (!S.next(0, cur)) return;
    f32x4 acc[2][2][4][2];
#pragma unroll
    for (int a = 0; a < 2; ++a)
#pragma unroll
        for (int b = 0; b < 2; ++b)
#pragma unroll
            for (int m = 0; m < 4; ++m)
#pragma unroll
                for (int n = 0; n < 2; ++n) acc[a][b][m][n] = (f32x4){0.f, 0.f, 0.f, 0.f};
    bf16x8 At[4][2], B0[2][2], B1[2][2];
    const char* cA = (const char*)g.A + (size_t)cur.pm * tstepA; const char* cB = (const char*)g.Bt + (size_t)cur.pn * tstepB;
    S.a_ready(cur);
    if constexpr (SP2) {
        PG8_STAGE(PG8_SB(0, 0), cB, voffB); PG8_STAGE(PG8_SB(0, 1), cB + hstepB, voffB); PG8_STAGE(PG8_SA(0, 0), cA, voffA); PG8_STAGE(PG8_SA(0, 1), cA + hstepA, voffA);
        if (wr == 1) PG8_BAR;
        PG8_WAIT_V(2); PG8_BAR;
        PG8_STAGE(PG8_SB(1, 0), cB + kstep, voffB); PG8_STAGE(PG8_SA(1, 0), cA + kstep, voffA); PG8_STAGE(PG8_SB(1, 1), cB + hstepB + kstep, voffB);
        PG8_WAIT_V(6); PG8_BAR;
    } else {
        PG8_STAGE(PG8_SB(0, 0), cB, voffB); PG8_STAGE(PG8_SA(0, 0), cA, voffA); PG8_STAGE(PG8_SB(0, 1), cB + hstepB, voffB); PG8_STAGE(PG8_SA(0, 1), cA + hstepA, voffA);
        if (wr == 1) PG8_BAR;
        PG8_WAIT_V(4); PG8_BAR;
        PG8_STAGE(PG8_SB(1, 0), cB + kstep, voffB); PG8_STAGE(PG8_SA(1, 0), cA + kstep, voffA); PG8_STAGE(PG8_SB(1, 1), cB + hstepB + kstep, voffB);
        PG8_WAIT_V(6); PG8_BAR;
    }
    for (;;) {
        const bool has_next = S.next(ui + 1, nxt);
        const char* nA = has_next ? (const char*)g.A + (size_t)nxt.pm * tstepA : cA; const char* nB = has_next ? (const char*)g.Bt + (size_t)nxt.pn * tstepB : cB;
        for (int t = 0; t < nt; t += 2) {
            if constexpr (Epi::MIDK) { if (t == E.t1 || t == E.t2) E.mid(acc, cur, t, wr, wc, fr, fq); }
            const bool last = (t == nt - 2);
            const char* a1 = cA + (size_t)(t + 1) * kstep;
            const char* a2 = last ? nA : cA + (size_t)(t + 2) * kstep; const char* b2 = last ? nB : cB + (size_t)(t + 2) * kstep;
            const char* a3 = a2 + kstep; const char* b3 = b2 + kstep;
            if (last && has_next) S.a_ready(nxt);
            if constexpr (SP2) {
            PG8_LDB(B0, 0, 0); PG8_LDB(B1, 0, 1); PG8_SCHED; PG8_LDA(At, 0, 0); PG8_STAGE(PG8_SA(1, 1), a1 + hstepA, voffA);
            PG8_WAIT_V(8); PG8_WAIT_L(0); PG8_BAR; PG8_MMA(0, 0, At, B0); PG8_MMA(0, 1, At, B1); PG8_BAR; PG8_SCHED;
            PG8_LDA(At, 0, 1); PG8_STAGE(PG8_SB(0, 0), b2, voffB); PG8_STAGE(PG8_SB(0, 1), b2 + hstepB, voffB); PG8_STAGE(PG8_SA(0, 0), a2, voffA);
            PG8_WAIT_V(8); PG8_WAIT_L(0); PG8_BAR; PG8_MMA(1, 0, At, B0); PG8_MMA(1, 1, At, B1); PG8_BAR; PG8_SCHED;
            PG8_LDB(B0, 1, 0); PG8_LDB(B1, 1, 1); PG8_SCHED; PG8_LDA(At, 1, 0); PG8_STAGE(PG8_SA(0, 1), a2 + hstepA, voffA);
            PG8_WAIT_V(8); PG8_WAIT_L(0); PG8_BAR; PG8_MMA(0, 0, At, B0); PG8_MMA(0, 1, At, B1); PG8_BAR; PG8_SCHED;
            PG8_LDA(At, 1, 1); PG8_STAGE(PG8_SB(1, 0), b3, voffB); PG8_STAGE(PG8_SB(1, 1), b3 + hstepB, voffB); PG8_STAGE(PG8_SA(1, 0), a3, voffA);
            PG8_WAIT_V(8); PG8_WAIT_L(0); PG8_BAR; PG8_MMA(1, 0, At, B0); PG8_MMA(1, 1, At, B1); PG8_BAR; PG8_SCHED;
            } else {
            PG8_LDB(B0, 0, 0); PG8_SCHED; PG8_LDA(At, 0, 0); PG8_STAGE(PG8_SA(1, 1), a1 + hstepA, voffA);
            PG8_WAIT_L(8); PG8_BAR; PG8_WAIT_L(0); PG8_MMA(0, 0, At, B0); PG8_BAR; PG8_SCHED;
            PG8_LDB(B1, 0, 1); PG8_STAGE(PG8_SB(0, 0), b2, voffB);
            PG8_BAR; PG8_WAIT_L(0); PG8_MMA(0, 1, At, B1); PG8_BAR;
            PG8_LDA(At, 0, 1); PG8_STAGE(PG8_SA(0, 0), a2, voffA);
            PG8_BAR; PG8_WAIT_L(0); PG8_MMA(1, 0, At, B0); PG8_BAR; PG8_SCHED;
            PG8_STAGE(PG8_SB(0, 1), b2 + hstepB, voffB);
            PG8_WAIT_V(6); PG8_BAR; PG8_MMA(1, 1, At, B1); PG8_BAR;
            PG8_LDB(B0, 1, 0); PG8_SCHED; PG8_LDA(At, 1, 0); PG8_STAGE(PG8_SA(0, 1), a2 + hstepA, voffA);
            PG8_WAIT_L(8); PG8_BAR; PG8_WAIT_L(0); PG8_MMA(0, 0, At, B0); PG8_BAR; PG8_SCHED;
            PG8_LDB(B1, 1, 1); PG8_STAGE(PG8_SB(1, 0), b3, voffB);
            PG8_BAR; PG8_WAIT_L(0); PG8_MMA(0, 1, At, B1); PG8_BAR;
            PG8_LDA(At, 1, 1); PG8_STAGE(PG8_SA(1, 0), a3, voffA);
            PG8_BAR; PG8_WAIT_L(0); PG8_MMA(1, 0, At, B0); PG8_BAR; PG8_SCHED;
            PG8_STAGE(PG8_SB(1, 1), b3 + hstepB, voffB);
            PG8_WAIT_V(6); PG8_BAR; PG8_MMA(1, 1, At, B1); PG8_BAR;
            }
        }
        if constexpr (ALIGN_EPI) { if (wr == 0) PG8_BAR; }
        if constexpr (!Epi::AFTER_DRAIN) { E(acc, cur, wr, wc, fr, fq); S.done(cur); }
        if (!has_next) break;
#pragma unroll
        for (int a = 0; a < 2; ++a)
#pragma unroll
            for (int b = 0; b < 2; ++b)
#pragma unroll
                for (int m = 0; m < 4; ++m)
#pragma unroll
                    for (int n = 0; n < 2; ++n) acc[a][b][m][n] = (f32x4){0.f, 0.f, 0.f, 0.f};
        cur = nxt; cA = nA; cB = nB; ++ui;
        if constexpr (ALIGN_EPI) { if (wr == 1) PG8_BAR; }
    }
    PG8_WAIT_V(0);
    if constexpr (!ALIGN_EPI) { if (wr == 0) PG8_BAR; }
    PG8_BAR;
    if constexpr (Epi::AFTER_DRAIN) { E.fused(acc, cur, wr, wc, fr, fq, lds, wid, lane); S.done(cur); }
#undef PG8_SA
#undef PG8_SB
#undef PG8_STAGE
#undef PG8_LDA
#undef PG8_LDB
#undef PG8_MMA
#undef PG8_WAIT_V
#undef PG8_WAIT_L
#undef PG8_BAR
#undef PG8_SCHED
}
}
#define GAS __attribute__((address_space(1)))
#define LAS __attribute__((address_space(3)))
typedef unsigned short bf16;
typedef unsigned v4u __attribute__((ext_vector_type(4)));
typedef float f32x4 __attribute__((ext_vector_type(4)));
typedef short bf16x8 __attribute__((ext_vector_type(8)));
typedef GAS unsigned gu32;
typedef GAS unsigned long long gu64;
#define RLX_AGENT __ATOMIC_RELAXED, __HIP_MEMORY_SCOPE_AGENT
#define LDS_WAIT() asm volatile("s_waitcnt lgkmcnt(0)" ::: "memory")
#define VM_WAIT() asm volatile("s_waitcnt vmcnt(0)" ::: "memory")
__device__ __forceinline__ unsigned long long rt() { return __builtin_amdgcn_s_memrealtime(); }
__device__ __forceinline__ unsigned f2bf(float f) { unsigned u = __builtin_bit_cast(unsigned, f); return (u + 0x7fffu + ((u >> 16) & 1u)) >> 16; }
__device__ __forceinline__ unsigned pk2(float lo, float hi) { return f2bf(lo) | (f2bf(hi) << 16); }

#define XB_TMO      128
#define XB_XCNT(j)  (256  + 64 * (j))
#define XB_XSUB(j)  (1280 + 64 * (j))
#define XB_XGEN(j)  (2304 + 64 * (j))
#define XB_TOP      3328
#define XB_TOPGEN   3392
#define XCD_BAR_WORDS 3456
#define XB_SPIN_CAP (1u << 18)

__device__ __forceinline__ unsigned xb_ld(unsigned* p)              { return __hip_atomic_load(p, __ATOMIC_RELAXED, __HIP_MEMORY_SCOPE_AGENT); }
__device__ __forceinline__ unsigned xb_add(unsigned* p, unsigned v) { return __hip_atomic_fetch_add(p, v, __ATOMIC_RELAXED, __HIP_MEMORY_SCOPE_AGENT); }
__device__ __forceinline__ unsigned xb_xcc_id() { return (unsigned)__builtin_amdgcn_s_getreg((3 << 11) | 20) & 0xFu; }
#define XB_SPIN(cond, bar) do { unsigned _sp = 0; while (cond) { __builtin_amdgcn_s_sleep(1); \
    if ((++_sp & 255u) == 0u) { if (xb_ld(&(bar)[XB_TMO])) break; if (_sp > XB_SPIN_CAP) { atomicAdd(&(bar)[XB_TMO], 1u); break; } } } } while (0)

struct XcdBarrier {
    unsigned* bar; unsigned x;
    volatile LAS unsigned* st;
};

__device__ __forceinline__ XcdBarrier xcd_barrier_post(unsigned* bar, volatile LAS unsigned* st) {
    XcdBarrier b; b.bar = bar; b.x = xb_xcc_id(); b.st = st;
    if (threadIdx.x == 0) (void)xb_add(&bar[XB_XCNT(b.x)], 1u);
    return b;
}
__device__ __forceinline__ void xcd_barrier_complete(unsigned* bar, unsigned x, unsigned& nloc, unsigned& nx) {
    const unsigned G = gridDim.x * gridDim.y * gridDim.z;
    unsigned sum, cnt, mine, sp = 0u;
    for (;;) {
        sum = 0u; cnt = 0u; mine = 0u;
#pragma unroll
        for (unsigned j = 0; j < 16; ++j) { const unsigned c = xb_ld(&bar[XB_XCNT(j)]); sum += c; cnt += (c > 0u) ? 1u : 0u; mine = (j == x) ? c : mine; }
        if (sum == G) break;
        __builtin_amdgcn_s_sleep(1);
        if ((++sp & 255u) == 0u) { if (xb_ld(&bar[XB_TMO])) break; if (sp > XB_SPIN_CAP) { atomicAdd(&bar[XB_TMO], 1u); break; } }
    }
    nloc = mine > 0u ? mine : 1u; nx = cnt > 0u ? cnt : 1u;
}

__device__ __forceinline__ void xcd_barrier(const XcdBarrier& b) {
    asm volatile("s_waitcnt vmcnt(0)" ::: "memory");
    __syncthreads();
    if (threadIdx.x == 0) {
        unsigned* bar = b.bar;
        __builtin_amdgcn_s_waitcnt(0);
        unsigned nloc = b.st[0], nx = b.st[1];
        if (nloc == 0u) { xcd_barrier_complete(bar, b.x, nloc, nx); b.st[0] = nloc; b.st[1] = nx; }
        const unsigned old = xb_add(&bar[XB_XSUB(b.x)], 1u);
        const unsigned gen = old / nloc;
        if (old + 1u == (gen + 1u) * nloc) {
            __builtin_amdgcn_fence(__ATOMIC_RELEASE, "agent");
            asm volatile("s_waitcnt vmcnt(0)" ::: "memory");
            const unsigned og = xb_add(&bar[XB_TOP], 1u);
            const unsigned tg = og / nx;
            if (og + 1u == (tg + 1u) * nx) xb_add(&bar[XB_TOPGEN], 1u);
            else XB_SPIN(xb_ld(&bar[XB_TOPGEN]) == tg, bar);
            __builtin_amdgcn_fence(__ATOMIC_ACQUIRE, "agent");
            xb_add(&bar[XB_XGEN(b.x)], 1u);
            asm volatile("s_waitcnt vmcnt(0)" ::: "memory");
        } else {
            XB_SPIN(xb_ld(&bar[XB_XGEN(b.x)]) == gen, bar);
            __builtin_amdgcn_fence(__ATOMIC_ACQUIRE, "agent");
            asm volatile("s_waitcnt vmcnt(0)" ::: "memory");
        }
    }
    __syncthreads();
}

namespace pg8 {
__device__ __forceinline__ unsigned cvt_pk_bf16(float lo, float hi) { unsigned r; asm volatile("v_cvt_pk_bf16_f32 %0, %1, %2" : "=v"(r) : "v"(lo), "v"(hi)); return r; }
__device__ __forceinline__ float bflo(unsigned w) { return __uint_as_float(w << 16); }
__device__ __forceinline__ float bfhi(unsigned w) { return __uint_as_float(w & 0xffff0000u); }
__device__ __forceinline__ float fast_sigmoid(float x) { return __builtin_amdgcn_rcpf(1.0f + __builtin_amdgcn_exp2f(-1.4426950408889634f * x)); }

struct EpiSwiglu {
    static constexpr bool PERM = true, AFTER_DRAIN = false, MIDK = false;
    bf16_t* H; int ldh;
    __device__ __forceinline__ void operator()(const f32x4 (&acc)[2][2][4][2], const Unit& u, int wr, int wc, int fr, int fq) const {
        const int row0 = u.pm * BM + wr * 64 + fr, col0 = u.pn * HALF + wc * 32 + 8 * fq;
#pragma unroll
        for (int ai = 0; ai < 2; ++ai)
#pragma unroll
            for (int m = 0; m < 4; ++m) { bf16_t* rowp = H + (size_t)(row0 + ai * HALF + m * 16) * ldh + col0;
                float h[8];
#pragma unroll
                for (int n = 0; n < 2; ++n)
#pragma unroll
                    for (int j = 0; j < 4; ++j) { const float a = acc[ai][0][m][n][j], b = acc[ai][1][m][n][j]; h[n * 4 + j] = a * fast_sigmoid(a) * b; }
                u32x4 w; w.x = cvt_pk_bf16(h[0], h[1]); w.y = cvt_pk_bf16(h[2], h[3]); w.z = cvt_pk_bf16(h[4], h[5]); w.w = cvt_pk_bf16(h[6], h[7]);
                *(u32x4*)rowp = w; }
    }
};
struct EpiRes {
    static constexpr bool PERM = false, AFTER_DRAIN = false, MIDK = false;
    const float* base; float* out; int ld; float s;
    __device__ __forceinline__ void operator()(const f32x4 (&acc)[2][2][4][2], const Unit& u, int wr, int wc, int fr, int fq) const {
        const int row0 = u.pm * BM + wr * 64 + fr, col0 = u.pn * BM + wc * 32 + 4 * fq;
#pragma unroll
        for (int ai = 0; ai < 2; ++ai)
#pragma unroll
            for (int m = 0; m < 4; ++m) { const size_t off = (size_t)(row0 + ai * HALF + m * 16) * ld + col0;
#pragma unroll
                for (int bj = 0; bj < 2; ++bj)
#pragma unroll
                    for (int n = 0; n < 2; ++n) { const f32x4 b = *(const f32x4*)(base + off + bj * HALF + n * 16); *(f32x4*)(out + off + bj * HALF + n * 16) = b + acc[ai][bj][m][n] * s; } }
    }
};
struct EpiCols {
    static constexpr bool PERM = true, AFTER_DRAIN = false, MIDK = false;
    bf16_t* O; int ldc; int sig_from;
    __device__ __forceinline__ void operator()(const f32x4 (&acc)[2][2][4][2], const Unit& u, int wr, int wc, int fr, int fq) const {
        const int row0 = u.pm * BM + wr * 64 + fr, col0 = u.pn * BM + wc * 32 + 8 * fq; const bool sg = u.pn >= sig_from;
#pragma unroll
        for (int ai = 0; ai < 2; ++ai)
#pragma unroll
            for (int m = 0; m < 4; ++m) { bf16_t* rowp = O + (size_t)(row0 + ai * HALF + m * 16) * ldc + col0;
#pragma unroll
                for (int bj = 0; bj < 2; ++bj) { f32x4 v0 = acc[ai][bj][m][0], v1 = acc[ai][bj][m][1];
                    if (sg) {
#pragma unroll
                        for (int j = 0; j < 4; ++j) { v0[j] = fmaxf(fast_sigmoid(v0[j]), 1e-6f); v1[j] = fmaxf(fast_sigmoid(v1[j]), 1e-6f); } }
                    u32x4 w; w.x = cvt_pk_bf16(v0[0], v0[1]); w.y = cvt_pk_bf16(v0[2], v0[3]); w.z = cvt_pk_bf16(v1[0], v1[1]); w.w = cvt_pk_bf16(v1[2], v1[3]);
                    *(u32x4*)(rowp + bj * HALF) = w; } }
    }
};
struct EpiProjF {
    static constexpr bool PERM = true, AFTER_DRAIN = false, MIDK = true;
    const bf16_t* G; int ldg; bf16_t* Z; int ld; int t1, t2;
    __device__ __forceinline__ void mid(f32x4 (&acc)[2][2][4][2], const Unit& u, int t, int wr, int wc, int fr, int fq) const {
        int fr_l = fr; asm volatile("" : "+v"(fr_l));
        const int seg = t == t1 ? 0 : 1; const int row0 = u.pm * BM + wr * 64 + fr_l, col0 = u.pn * BM + wc * 32 + 8 * fq;
#pragma unroll
        for (int ai = 0; ai < 2; ++ai)
#pragma unroll
          for (int mh = 0; mh < 2; ++mh) { u32x4 ga[2][2], gb[2][2];
#pragma unroll
            for (int mm = 0; mm < 2; ++mm)
#pragma unroll
                for (int bj = 0; bj < 2; ++bj) { const bf16_t* gp = G + (size_t)(row0 + ai * HALF + (mh * 2 + mm) * 16) * ldg + seg * 2048 + col0 + bj * HALF; ga[mm][bj] = *(const u32x4*)gp; gb[mm][bj] = *(const u32x4*)(gp + 2048); }
            asm volatile("s_waitcnt vmcnt(0)" ::: "memory");
#pragma unroll
            for (int mm = 0; mm < 2; ++mm)
#pragma unroll
                for (int bj = 0; bj < 2; ++bj) { const u32x4 a = ga[mm][bj], b = gb[mm][bj]; const int m = mh * 2 + mm;
                    const f32x4 r0 = {bflo(a.x) * __builtin_amdgcn_rcpf(bflo(b.x)), bfhi(a.x) * __builtin_amdgcn_rcpf(bfhi(b.x)), bflo(a.y) * __builtin_amdgcn_rcpf(bflo(b.y)), bfhi(a.y) * __builtin_amdgcn_rcpf(bfhi(b.y))};
                    const f32x4 r1 = {bflo(a.z) * __builtin_amdgcn_rcpf(bflo(b.z)), bfhi(a.z) * __builtin_amdgcn_rcpf(bfhi(b.z)), bflo(a.w) * __builtin_amdgcn_rcpf(bflo(b.w)), bfhi(a.w) * __builtin_amdgcn_rcpf(bfhi(b.w))};
                    acc[ai][bj][m][0] *= r0; acc[ai][bj][m][1] *= r1; }
            asm volatile("" ::: "memory"); }
    }
    __device__ __forceinline__ void operator()(const f32x4 (&acc)[2][2][4][2], const Unit& u, int wr, int wc, int fr, int fq) const {
        const int row0 = u.pm * BM + wr * 64 + fr, col0 = u.pn * BM + wc * 32 + 8 * fq;
#pragma unroll
        for (int ai = 0; ai < 2; ++ai)
#pragma unroll
            for (int m = 0; m < 4; ++m) { const int row = row0 + ai * HALF + m * 16;
#pragma unroll
                for (int bj = 0; bj < 2; ++bj) { const int col = col0 + bj * HALF; const u32x4 gw = *(const u32x4*)(G + (size_t)row * ldg + 4096 + col);
                    const f32x4 g0 = {bflo(gw.x), bfhi(gw.x), bflo(gw.y), bfhi(gw.y)}, g1 = {bflo(gw.z), bfhi(gw.z), bflo(gw.w), bfhi(gw.w)};
                    const f32x4 v0 = acc[ai][bj][m][0] * g0, v1 = acc[ai][bj][m][1] * g1;
                    u32x4 w; w.x = cvt_pk_bf16(v0[0], v0[1]); w.y = cvt_pk_bf16(v0[2], v0[3]); w.z = cvt_pk_bf16(v1[0], v1[1]); w.w = cvt_pk_bf16(v1[2], v1[3]);
                    *(u32x4*)(Z + (size_t)row * ld + col) = w; } }
    }
};
}

#ifndef MK_FILLER
#define MK_FILLER 1
#endif
#ifndef PROBE_BAR2
#define PROBE_BAR2 0
#endif
#ifndef PROBE_SUB
#define PROBE_SUB 0
#endif
constexpr int NWAVES = 8;
constexpr int DM = 2048, NB = 4, SEQ = 2048, DEPTH = 4, MTOK = NB * SEQ, DFF = 5632;
constexpr int NCOLS = 11520;
constexpr int C_QA = 0, C_KA = 768, C_VA = 1536, C_XB = 2304, C_QC = 2816, C_KCMP = 3584, C_VCMP = 3840, C_KSLC = 4096, C_VSLC = 4352, C_KWIN = 4608, C_VWIN = 4864,
              C_GM = 5120  , C_GC = 11264  ;
constexpr int SIG_TILE = C_GM / 256;
constexpr int NBR = 1536;
constexpr float EPS = 1e-6f;
constexpr int NPH_LAYER = 13, NPHASES = 1 + DEPTH * NPH_LAYER;

constexpr size_t MiB = 1u << 20;
constexpr size_t WS_CTL = 0, CTL_ZERO_BYTES = 1 * MiB;
constexpr size_t WS_W = 2 * MiB, W_LAYER = 194 * MiB;
constexpr size_t WO_WI1 = 0, WO_WO1 = 44 * MiB, WO_WIN = 66 * MiB, WO_PROJ = 111 * MiB, WO_WOUT = 117 * MiB, WO_WI2 = 125 * MiB, WO_WO2 = 169 * MiB,
                 WO_C1K = 191 * MiB, WO_C1V = 192 * MiB, WO_C2K = 193 * MiB, WO_C2V = 193 * MiB + 32768, WO_POOL = 193 * MiB + 65536, WO_PEB = 193 * MiB + 262144;
constexpr size_t WS_XN = 780 * MiB, WS_H = 812 * MiB, WS_COLS = 900 * MiB, WS_BR = 1080 * MiB, WS_ZF = 1104 * MiB, WS_Z = 1168 * MiB, WS_OG = 1200 * MiB, WS_LSE = 1224 * MiB,
                 WS_OC = 1225 * MiB, WS_OW = 1249 * MiB, WS_SEL = 1273 * MiB, WS_KC = 1274 * MiB, WS_VC = 1274 * MiB + 512 * 1024, WS_END = 1276 * MiB;
static_assert(WS_W + DEPTH * W_LAYER <= WS_XN, "weights");
static_assert(WS_H + (size_t)MTOK * DFF * 2 <= WS_COLS && WS_COLS + (size_t)MTOK * NCOLS * 2 <= WS_BR && WS_BR + (size_t)MTOK * NBR * 2 <= WS_ZF, "ws map");
constexpr int CW_BAR = 4096;

constexpr int RING_OFF = 0, RING_BYTES = 131072;
constexpr int LDSCTL_OFF = RING_BYTES, MISC_OFF = LDSCTL_OFF + 320;
constexpr int LDS_BYTES = 147456;

__device__ __forceinline__ float bf2f(bf16 h) { return __uint_as_float((unsigned)h << 16); }
__device__ __forceinline__ float wave_sum(float v) {
#pragma unroll
    for (int o = 1; o < 64; o <<= 1) v += __shfl_xor(v, o);
    return v;
}
__device__ __forceinline__ float wave_max(float v) {
#pragma unroll
    for (int o = 1; o < 64; o <<= 1) v = fmaxf(v, __shfl_xor(v, o));
    return v;
}
__device__ __forceinline__ void load8(const bf16* p, float (&f)[8]) {
    const v4u w = *(const v4u*)p;
    f[0] = pg8::bflo(w.x); f[1] = pg8::bfhi(w.x); f[2] = pg8::bflo(w.y); f[3] = pg8::bfhi(w.y); f[4] = pg8::bflo(w.z); f[5] = pg8::bfhi(w.z); f[6] = pg8::bflo(w.w); f[7] = pg8::bfhi(w.w);
}

struct Frame {
    LAS unsigned char* lds;
    volatile LAS unsigned* MISC;
    gu32* ctl;
    volatile LAS unsigned long long* tab;
    int tid, lane, wave, vcu, G, bx, gw, NGW;
};
__device__ __forceinline__ Frame make_frame(LAS unsigned char* lds, unsigned char* ws_ctl) {
    Frame F; int tid = (int)threadIdx.x, G = (int)gridDim.x, bx = (int)blockIdx.x;
    asm volatile("" : "+v"(tid)); asm volatile("" : "+s"(G), "+s"(bx));
    F.lds = lds; F.MISC = (volatile LAS unsigned*)(lds + MISC_OFF); F.tab = (volatile LAS unsigned long long*)(lds + LDSCTL_OFF);
    F.tid = tid; F.lane = tid & 63; F.wave = __builtin_amdgcn_readfirstlane(tid >> 6);
    F.G = G; F.bx = bx; F.vcu = (G % 8 == 0) ? (bx % 8) * (G / 8) + bx / 8 : bx;
    F.gw = F.vcu * NWAVES + F.wave; F.NGW = G * NWAVES; F.ctl = (gu32*)ws_ctl;
    return F;
}
__device__ __forceinline__ unsigned long long tab_get(const Frame& F, int i) {
    const unsigned long long v = F.tab[i];
    const unsigned lo = __builtin_amdgcn_readfirstlane((unsigned)v), hi = __builtin_amdgcn_readfirstlane((unsigned)(v >> 32));
    return ((unsigned long long)hi << 32) | lo;
}
__device__ __forceinline__ const float* in_ptr(const Frame& F, int i) { return (const float*)tab_get(F, i); }
__device__ __forceinline__ float* out_ptr(const Frame& F) { return (float*)tab_get(F, 22); }
__device__ __forceinline__ unsigned char* ws_ptr(const Frame& F) { return (unsigned char*)tab_get(F, 23); }

struct TrDesc { const float* W; bf16* WT; size_t r0; int ldn, c0, nv, k0, ldk, kofs; };
__device__ __forceinline__ void tr_item(const float* W, int ldn, int c0, int nv, int k0, bf16* WT, size_t r0, int ldk, int kofs, LAS float* scr, int lane) {
    float tv[32];
#pragma unroll
    for (int i = 0; i < 32; ++i) { const int kk = 2 * i + (lane >> 5), n = lane & 31; tv[i] = (n < nv) ? __builtin_nontemporal_load(W + (size_t)(k0 + kk) * ldn + c0 + n) : 0.f; }
#pragma unroll
    for (int i = 0; i < 32; ++i) { const int kk = 2 * i + (lane >> 5), n = lane & 31; scr[kk * 33 + n] = tv[i]; }
    LDS_WAIT(); asm volatile("" ::: "memory");
    const int c = lane & 7;
#pragma unroll
    for (int j = 0; j < 4; ++j) { const int n = (lane >> 3) + 8 * j; const LAS float* s = scr + (8 * c) * 33 + n;
        v4u o; o.x = pk2(s[0 * 33], s[1 * 33]); o.y = pk2(s[2 * 33], s[3 * 33]); o.z = pk2(s[4 * 33], s[5 * 33]); o.w = pk2(s[6 * 33], s[7 * 33]);
        *(GAS v4u*)(WT + (r0 + n) * (size_t)ldk + kofs + k0 + 8 * c) = o; }
    LDS_WAIT(); asm volatile("" ::: "memory");
}

__device__ __forceinline__ void tr_item2(const TrDesc& d0, const TrDesc& d1, LAS float* scr, int lane) {
    float tv[64];
#pragma unroll
    for (int i = 0; i < 32; ++i) { const int kk = 2 * i + (lane >> 5), n = lane & 31; tv[i] = (n < d0.nv) ? __builtin_nontemporal_load(d0.W + (size_t)(d0.k0 + kk) * d0.ldn + d0.c0 + n) : 0.f; }
#pragma unroll
    for (int i = 0; i < 32; ++i) { const int kk = 2 * i + (lane >> 5), n = lane & 31; tv[32 + i] = (n < d1.nv) ? __builtin_nontemporal_load(d1.W + (size_t)(d1.k0 + kk) * d1.ldn + d1.c0 + n) : 0.f; }
    const int c = lane & 7;
#pragma unroll
    for (int h = 0; h < 2; ++h) { const TrDesc& d = h ? d1 : d0;
#pragma unroll
        for (int i = 0; i < 32; ++i) { const int kk = 2 * i + (lane >> 5), n = lane & 31; scr[kk * 33 + n] = tv[h * 32 + i]; }
        LDS_WAIT(); asm volatile("" ::: "memory");
#pragma unroll
        for (int j = 0; j < 4; ++j) { const int n = (lane >> 3) + 8 * j; const LAS float* s = scr + (8 * c) * 33 + n;
            v4u o; o.x = pk2(s[0 * 33], s[1 * 33]); o.y = pk2(s[2 * 33], s[3 * 33]); o.z = pk2(s[4 * 33], s[5 * 33]); o.w = pk2(s[6 * 33], s[7 * 33]);
            *(GAS v4u*)(d.WT + (d.r0 + n) * (size_t)d.ldk + d.kofs + d.k0 + 8 * c) = o; }
        LDS_WAIT(); asm volatile("" ::: "memory"); }
}

constexpr int I_WI = 352 * 32, I_WO = 64 * 88, I_WIN = 360 * 32, I_PA = 64 * 4, I_PB = 64 * 8, I_PC = 64 * 12, I_WOUT = 64 * 32, I_C1 = 4 * 64, I_C2 = 4 * 2, I_POOL = 4 * 8;
constexpr int I_LAYER = 2 * I_WI + 2 * I_WO + I_WIN + I_PA + I_PB + I_PC + I_WOUT + 2 * I_C1 + 2 * I_C2 + I_POOL;

__device__ __forceinline__ TrDesc tr_decode(const Frame& F, unsigned char* ws, int l, int r) {
    unsigned char* wl = ws + WS_W + (size_t)l * W_LAYER;
    const float* W; int ldn, mode = 0, nrb, ldk, kofs = 0; bf16* WT;
    if (r < I_WI) { W = in_ptr(F, 2) + (size_t)l * DM * 2 * DFF; ldn = 2 * DFF; mode = 1; nrb = 352; WT = (bf16*)(wl + WO_WI1); ldk = DM; }
    else if ((r -= I_WI) < I_WO) { W = in_ptr(F, 3) + (size_t)l * DFF * DM; ldn = DM; nrb = 64; WT = (bf16*)(wl + WO_WO1); ldk = DFF; }
    else if ((r -= I_WO) < I_WIN) { W = in_ptr(F, 5) + (size_t)l * DM * 11282; ldn = 11282; mode = 2; nrb = 360; WT = (bf16*)(wl + WO_WIN); ldk = DM; }
    else if ((r -= I_WIN) < I_C1) { W = in_ptr(F, 9) + (size_t)l * 4096 * 128; ldn = 128; nrb = 4; WT = (bf16*)(wl + WO_C1K); ldk = 4096; }
    else if ((r -= I_C1) < I_C1) { W = in_ptr(F, 12) + (size_t)l * 4096 * 128; ldn = 128; nrb = 4; WT = (bf16*)(wl + WO_C1V); ldk = 4096; }
    else if ((r -= I_C1) < I_C2) { W = in_ptr(F, 10) + (size_t)l * 16384; ldn = 128; nrb = 4; WT = (bf16*)(wl + WO_C2K); ldk = 128; }
    else if ((r -= I_C2) < I_C2) { W = in_ptr(F, 13) + (size_t)l * 16384; ldn = 128; nrb = 4; WT = (bf16*)(wl + WO_C2V); ldk = 128; }
    else if ((r -= I_C2) < I_POOL) { const int gi = r >> 3; r &= 7; W = in_ptr(F, 6) + (size_t)(l * 4 + gi) * 16384; ldn = 128; nrb = 4; WT = (bf16*)(wl + WO_POOL) + gi * 16384; ldk = 128; }
    else if ((r -= I_POOL) < I_PA) { W = in_ptr(F, 14) + (size_t)l * 256 * DM; ldn = DM; nrb = 64; WT = (bf16*)(wl + WO_PROJ); ldk = NBR; kofs = 0; }
    else if ((r -= I_PA) < I_PB) { W = in_ptr(F, 15) + (size_t)l * 512 * DM; ldn = DM; nrb = 64; WT = (bf16*)(wl + WO_PROJ); ldk = NBR; kofs = 256; }
    else if ((r -= I_PB) < I_PC) { W = in_ptr(F, 16) + (size_t)l * 768 * DM; ldn = DM; nrb = 64; WT = (bf16*)(wl + WO_PROJ); ldk = NBR; kofs = 768; }
    else if ((r -= I_PC) < I_WOUT) { W = in_ptr(F, 17) + (size_t)l * DM * DM; ldn = DM; nrb = 64; WT = (bf16*)(wl + WO_WOUT); ldk = DM; }
    else if ((r -= I_WOUT) < I_WI) { W = in_ptr(F, 19) + (size_t)l * DM * 2 * DFF; ldn = 2 * DFF; mode = 1; nrb = 352; WT = (bf16*)(wl + WO_WI2); ldk = DM; }
    else { r -= I_WI; W = in_ptr(F, 20) + (size_t)l * DFF * DM; ldn = DM; nrb = 64; WT = (bf16*)(wl + WO_WO2); ldk = DFF; }
    const int kb = r / nrb, rb = r - kb * nrb; int c0 = 32 * rb, nv = 32;
    if (mode == 1) { const int t = rb >> 3, w = rb & 7; c0 = w < 4 ? t * 128 + w * 32 : DFF + t * 128 + (w - 4) * 32; }
    else if (mode == 2) { const int d0 = 32 * rb; if (d0 < C_GM) c0 = d0; else if (d0 < C_GC) c0 = d0 + 18; else if (d0 == C_GC) { c0 = 5120; nv = 18; } else { c0 = 0; nv = 0; } }
    TrDesc d; d.W = W; d.WT = WT; d.r0 = (size_t)32 * rb; d.ldn = ldn; d.c0 = c0; d.nv = nv; d.k0 = 64 * kb; d.ldk = ldk; d.kofs = kofs; return d;
}
constexpr int FILL_A = 16384, FILL_B = 11264, FILL_C = 16384, FILL_L = FILL_A + FILL_B + FILL_C, TR_TOTAL = DEPTH * I_LAYER;
constexpr int NEED_WI1 = I_WI, NEED_WO1 = NEED_WI1 + I_WO, NEED_WIN = NEED_WO1 + I_WIN, NEED_WOUT = NEED_WIN + 2 * I_C1 + 2 * I_C2 + I_POOL + I_PA + I_PB + I_PC + I_WOUT, NEED_WI2 = NEED_WOUT + I_WI, NEED_WO2 = NEED_WI2 + I_WO;
static_assert(NEED_WO2 == I_LAYER, "item order");
constexpr int tr_pro_min() { int p = 0;
    for (int l = 0; l < DEPTH; ++l) { const int base = l * I_LAYER, cap = l * FILL_L;
        const int n1 = base + NEED_WI1 - cap, n2 = base + NEED_WIN - (cap + FILL_A), n3 = base + NEED_WI2 - (cap + FILL_A + FILL_B), n4 = base + NEED_WO2 - (cap + FILL_L);
        p = n1 > p ? n1 : p; p = n2 > p ? n2 : p; p = n3 > p ? n3 : p; p = n4 > p ? n4 : p; }
    return p; }
constexpr int TR_PRO = MK_FILLER ? tr_pro_min() : TR_TOTAL;
__device__ __forceinline__ void tr_run(const Frame& F, unsigned char* ws, int first, int end, int stride) {
    LAS float* scr = (LAS float*)(F.lds + RING_OFF + F.wave * 16384);
#define TR_DEC(g_) tr_decode(F, ws, (g_) / I_LAYER, (g_) % I_LAYER)
    int it = first;
    for (; it + stride < end; it += 2 * stride) { const TrDesc d0 = TR_DEC(it); const TrDesc d1 = TR_DEC(it + stride); tr_item2(d0, d1, scr, F.lane); }
    if (it < end) { const TrDesc d = TR_DEC(it); tr_item(d.W, d.ldn, d.c0, d.nv, d.k0, d.WT, d.r0, d.ldk, d.kofs, scr, F.lane); }
#undef TR_DEC
}
__device__ __forceinline__ void tr_filler(const Frame& F, int g0, int n, int first_idle) {
    if (F.bx < first_idle) return;
    const int g1 = g0 + n < TR_TOTAL ? g0 + n : TR_TOTAL;
    tr_run(F, ws_ptr(F), g0 + (F.bx - first_idle) * NWAVES + F.wave, g1, (F.G - first_idle) * NWAVES);
}
struct Args { const float* in[22]; float* out; unsigned char* ws; int ph_lo, ph_hi; };

__device__ __forceinline__ void rmsnorm_rows_bf16(const Frame& F, const float* src, const float* gain, bf16* dst) {
    for (int m = F.gw; m < MTOK; m += F.NGW) {
        const GAS f32x4* xr = (const GAS f32x4*)(src + (size_t)m * DM) + F.lane;
        f32x4 v[8]; float s = 0.f;
#pragma unroll
        for (int j = 0; j < 8; ++j) { v[j] = xr[64 * j]; s += (v[j].x * v[j].x + v[j].y * v[j].y) + (v[j].z * v[j].z + v[j].w * v[j].w); }
        const float r = 1.0f / sqrtf(wave_sum(s) * (1.0f / DM) + EPS);
        GAS unsigned long long* o8 = (GAS unsigned long long*)(dst + (size_t)m * DM) + F.lane;
#pragma unroll
        for (int j = 0; j < 8; ++j) { const f32x4 g = ((const GAS f32x4*)gain)[F.lane + 64 * j];
            o8[64 * j] = (unsigned long long)pk2(v[j].x * r * g.x, v[j].y * r * g.y) | ((unsigned long long)pk2(v[j].z * r * g.z, v[j].w * r * g.w) << 32); }
    }
}
__device__ __forceinline__ void rmsnorm_rows_f32(const Frame& F, const float* src, const float* gain, float* dst) {
    for (int m = F.gw; m < MTOK; m += F.NGW) {
        const GAS f32x4* xr = (const GAS f32x4*)(src + (size_t)m * DM) + F.lane;
        f32x4 v[8]; float s = 0.f;
#pragma unroll
        for (int j = 0; j < 8; ++j) { v[j] = xr[64 * j]; s += (v[j].x * v[j].x + v[j].y * v[j].y) + (v[j].z * v[j].z + v[j].w * v[j].w); }
        const float r = 1.0f / sqrtf(wave_sum(s) * (1.0f / DM) + EPS);
        GAS f32x4* o = (GAS f32x4*)(dst + (size_t)m * DM) + F.lane;
#pragma unroll
        for (int j = 0; j < 8; ++j) { const f32x4 g = ((const GAS f32x4*)gain)[F.lane + 64 * j]; o[64 * j] = v[j] * r * g; }
    }
}


namespace att {
typedef short bf16x8 __attribute__((ext_vector_type(8)));
constexpr int KP = 272;
constexpr int VP = 240;
__host__ __device__ constexpr int tile_bytes(int DH) { return 64 * KP + DH * VP; }
__device__ __forceinline__ int slotpos(int k) { return (k & 32) | (((k >> 2) & 3) << 3) | (((k >> 4) & 1) << 2) | (k & 3); }
constexpr float NEGB = -1e30f;

template <int DH, int NH, int KSPLIT, class P>
__device__ __forceinline__ void attn_unit(const Frame& F, const P& pol) {
    constexpr int NSLAB = 8 / KSPLIT, KS = DH / 32, DT = DH / 16, CPR = DH / 8  ;
    constexpr int KCH = (64 * CPR) / 512, VT = 32 * CPR, KBYTES = 64 * KP, TILE = tile_bytes(DH);
    static_assert(KCH >= 1 && VT <= 512 && KSPLIT * TILE <= RING_BYTES, "attention tile geometry");
    LAS unsigned char* const L = F.lds + RING_OFF;
    const int tid = F.tid, lane = F.lane, wave = F.wave, qi = lane & 15, qg = lane >> 4;
    const int slab = wave % NSLAB, kgrp = wave / NSLAB, iq = slab * 16 + qi;
    bf16x8 qf[NH][KS];
#pragma unroll
    for (int h = 0; h < NH; ++h)
#pragma unroll
        for (int ks = 0; ks < KS; ++ks) qf[h][ks] = *(const bf16x8*)(pol.qptr(iq, h) + ks * 32 + qg * 8);
    float m[NH], l[NH]; f32x4 o[NH][DT];
#pragma unroll
    for (int h = 0; h < NH; ++h) { m[h] = NEGB; l[h] = 0.f;
#pragma unroll
        for (int dt = 0; dt < DT; ++dt) o[h][dt] = (f32x4){0.f, 0.f, 0.f, 0.f}; }
    const int kt_lo = pol.kt_lo, kt_hi = pol.kt_hi, n_iter = (kt_hi - kt_lo + KSPLIT - 1) / KSPLIT;
    v4u kreg[KSPLIT][KCH], vreg[KSPLIT][2];
    const int vkp = tid & 31, vdc = tid >> 5;
#define ATT_PREFETCH(it_) do { _Pragma("unroll") for (int ts = 0; ts < KSPLIT; ++ts) { int kt_ = kt_lo + (it_) * KSPLIT + ts; kt_ = kt_ < kt_hi ? kt_ : kt_hi - 1; \
        _Pragma("unroll") for (int c = 0; c < KCH; ++c) { const int ch = tid + 512 * c; kreg[ts][c] = *(const v4u*)(pol.kptr(kt_ * 64 + ch / CPR) + (ch % CPR) * 8); } \
        if (VT == 512 || tid < VT) { vreg[ts][0] = *(const v4u*)(pol.vptr(kt_ * 64 + 2 * vkp) + vdc * 8); vreg[ts][1] = *(const v4u*)(pol.vptr(kt_ * 64 + 2 * vkp + 1) + vdc * 8); } } } while (0)
    ATT_PREFETCH(0);
    for (int it = 0; it < n_iter; ++it) {
        __syncthreads();
#pragma unroll
        for (int ts = 0; ts < KSPLIT; ++ts) { LAS unsigned char* base = L + ts * TILE;
#pragma unroll
            for (int c = 0; c < KCH; ++c) { const int ch = tid + 512 * c; *(LAS v4u*)(base + (ch / CPR) * KP + (ch % CPR) * 16) = kreg[ts][c]; }
            if (VT == 512 || tid < VT) { LAS unsigned char* vb = base + KBYTES + (vdc * 8) * VP + slotpos(2 * vkp) * 2; const v4u a = vreg[ts][0], b = vreg[ts][1];
                *(LAS unsigned*)(vb + 0 * VP) = (a.x & 0xffffu) | (b.x << 16); *(LAS unsigned*)(vb + 1 * VP) = (a.x >> 16) | (b.x & 0xffff0000u);
                *(LAS unsigned*)(vb + 2 * VP) = (a.y & 0xffffu) | (b.y << 16); *(LAS unsigned*)(vb + 3 * VP) = (a.y >> 16) | (b.y & 0xffff0000u);
                *(LAS unsigned*)(vb + 4 * VP) = (a.z & 0xffffu) | (b.z << 16); *(LAS unsigned*)(vb + 5 * VP) = (a.z >> 16) | (b.z & 0xffff0000u);
                *(LAS unsigned*)(vb + 6 * VP) = (a.w & 0xffffu) | (b.w << 16); *(LAS unsigned*)(vb + 7 * VP) = (a.w >> 16) | (b.w & 0xffff0000u); } }
        __syncthreads();
        if (it + 1 < n_iter) ATT_PREFETCH(it + 1);
        const int kt = kt_lo + it * KSPLIT + kgrp;
        if (kt < kt_hi && pol.wave_tile_active(kt)) {
            const LAS unsigned char* Kt = L + kgrp * TILE; const LAS unsigned char* Vt = Kt + KBYTES;
            bf16x8 pf[NH][2];
#pragma unroll
            for (int h = 0; h < NH; ++h) {
                f32x4 s[4];
#pragma unroll
                for (int nt = 0; nt < 4; ++nt) { s[nt] = (f32x4){0.f, 0.f, 0.f, 0.f};
#pragma unroll
                    for (int ks = 0; ks < KS; ++ks) { const bf16x8 kf = *(const LAS bf16x8*)(Kt + (nt * 16 + qi) * KP + (ks * 32 + qg * 8) * 2);
                        s[nt] = __builtin_amdgcn_mfma_f32_16x16x32_bf16(kf, qf[h][ks], s[nt], 0, 0, 0); } }
                float mx = NEGB;
#pragma unroll
                for (int nt = 0; nt < 4; ++nt)
#pragma unroll
                    for (int r = 0; r < 4; ++r) { const int k = kt * 64 + nt * 16 + qg * 4 + r; const float v = pol.valid(iq, k) ? s[nt][r] * P::SC : NEGB; s[nt][r] = v; mx = fmaxf(mx, v); }
                mx = fmaxf(mx, __shfl_xor(mx, 16)); mx = fmaxf(mx, __shfl_xor(mx, 32));
                const float mnew = fmaxf(m[h], mx), msafe = mnew <= NEGB ? 0.f : mnew;
                const float corr = __builtin_amdgcn_exp2f(m[h] - msafe); m[h] = mnew;
                float psum = 0.f;
#pragma unroll
                for (int nt = 0; nt < 4; ++nt)
#pragma unroll
                    for (int r = 0; r < 4; ++r) { const float p = __builtin_amdgcn_exp2f(s[nt][r] - msafe); s[nt][r] = p; psum += p; }
                l[h] = l[h] * corr + psum;
#pragma unroll
                for (int dt = 0; dt < DT; ++dt) o[h][dt] *= corr;
#pragma unroll
                for (int i = 0; i < 2; ++i) { v4u w; w.x = pg8::cvt_pk_bf16(s[2 * i][0], s[2 * i][1]); w.y = pg8::cvt_pk_bf16(s[2 * i][2], s[2 * i][3]);
                    w.z = pg8::cvt_pk_bf16(s[2 * i + 1][0], s[2 * i + 1][1]); w.w = pg8::cvt_pk_bf16(s[2 * i + 1][2], s[2 * i + 1][3]); pf[h][i] = __builtin_bit_cast(bf16x8, w); }
            }
#pragma unroll
            for (int dt = 0; dt < DT; ++dt)
#pragma unroll
                for (int i = 0; i < 2; ++i) { const bf16x8 vf = *(const LAS bf16x8*)(Vt + (dt * 16 + qi) * VP + (i * 32 + qg * 8) * 2);
#pragma unroll
                    for (int h = 0; h < NH; ++h) o[h][dt] = __builtin_amdgcn_mfma_f32_16x16x32_bf16(vf, pf[h][i], o[h][dt], 0, 0, 0); }
        }
    }
#undef ATT_PREFETCH
    if (KSPLIT == 2) {
        __syncthreads();
        LAS float* X = (LAS float*)L; constexpr int NV = DT * 4 + 2;
        if (kgrp == 1) {
#pragma unroll
            for (int h = 0; h < NH; ++h) { LAS float* xb = X + ((slab * NH + h) * NV) * 64 + lane; xb[0] = m[h]; xb[64] = l[h];
#pragma unroll
                for (int dt = 0; dt < DT; ++dt)
#pragma unroll
                    for (int r = 0; r < 4; ++r) xb[(2 + dt * 4 + r) * 64] = o[h][dt][r]; }
        }
        __syncthreads();
        if (kgrp == 0) {
#pragma unroll
            for (int h = 0; h < NH; ++h) { const LAS float* xb = X + ((slab * NH + h) * NV) * 64 + lane; const float mb = xb[0], lb = xb[64];
                const float mn = fmaxf(m[h], mb), ms = mn <= NEGB ? 0.f : mn; const float fa = __builtin_amdgcn_exp2f(m[h] - ms), fb = __builtin_amdgcn_exp2f(mb - ms);
                m[h] = mn; l[h] = l[h] * fa + lb * fb;
#pragma unroll
                for (int dt = 0; dt < DT; ++dt)
#pragma unroll
                    for (int r = 0; r < 4; ++r) o[h][dt][r] = o[h][dt][r] * fa + xb[(2 + dt * 4 + r) * 64] * fb; }
        }
    }
    if (kgrp == 0) {
#pragma unroll
        for (int h = 0; h < NH; ++h) { float lt = l[h]; lt += __shfl_xor(lt, 16); lt += __shfl_xor(lt, 32); const float inv = 1.0f / lt;
            if (qg == 0) pol.stats(iq, h, m[h], lt);
#pragma unroll
            for (int dt = 0; dt < DT; ++dt) pol.out4(iq, h, dt * 16 + qg * 4, o[h][dt] * inv); }
    }
    __syncthreads();
}

__device__ __forceinline__ void glds16(const void* gsrc, unsigned lds_dst) { unsigned keep;
    asm volatile("s_mov_b32 %0, m0\n\ts_mov_b32 m0, %2\n\ts_nop 0\n\tglobal_load_lds_dwordx4 %1, off\n\ts_mov_b32 m0, %0" : "=&s"(keep) : "v"(gsrc), "s"(lds_dst) : "memory"); }
template <int NH, class P>
__device__ __forceinline__ void attn_unit3(const Frame& F, const P& pol) {
    constexpr int KS = 4, DT = 8, TB = 16384, VBASE = 4 * TB;
    typedef short v4i16_t __attribute__((ext_vector_type(4)));
    LAS unsigned char* const L = F.lds + RING_OFF; const unsigned ldsaddr = (unsigned)(size_t)L;
    int tid_l = F.tid; asm volatile("" : "+v"(tid_l));
    const int tid = tid_l, lane = tid & 63, wave = __builtin_amdgcn_readfirstlane(tid >> 6), qi = lane & 15, qg = lane >> 4;
    const int slab = wave & 3, kgrp = wave >> 2, iq = slab * 16 + qi;
    const int rbq = ((qg & 1) << 3) | ((qg >> 1) << 2);
    const int krow = (((qi >> 2) & 1) << 3) | ((qi >> 3) << 2) | (qi & 3);
    bf16x8 qf[NH][KS];
#pragma unroll
    for (int h = 0; h < NH; ++h)
#pragma unroll
        for (int ks = 0; ks < KS; ++ks) qf[h][ks] = *(const bf16x8*)(pol.qptr(iq, h) + ks * 32 + qg * 8);
    float m[NH], l[NH]; f32x4 o[NH][DT];
#pragma unroll
    for (int h = 0; h < NH; ++h) { m[h] = NEGB; l[h] = 0.f;
#pragma unroll
        for (int dt = 0; dt < DT; ++dt) o[h][dt] = (f32x4){0.f, 0.f, 0.f, 0.f}; }
    const int kt_lo = pol.kt_lo, kt_hi = pol.kt_hi, n_iter = (kt_hi - kt_lo + 1) / 2;
    const int drow0 = wave * 8 + (lane >> 4), drow1 = drow0 + 4, cp = lane & 15;
    const int kc0 = (cp ^ (drow0 & 15)) * 8, kc1 = (cp ^ (drow1 & 15)) * 8;
    const int vc0 = (cp ^ (((drow0 & 3) << 2) | ((drow0 >> 2) & 3))) * 8, vc1 = (cp ^ (((drow1 & 3) << 2) | ((drow1 >> 2) & 3))) * 8;
#define ATT3_ISSUE(it_) do { _Pragma("unroll") for (int ts = 0; ts < 2; ++ts) { int kt_ = kt_lo + (it_) * 2 + ts; kt_ = kt_ < kt_hi ? kt_ : kt_hi - 1; \
        const unsigned dst_ = (unsigned)__builtin_amdgcn_readfirstlane((int)(ldsaddr + ((((it_) & 1) * 2 + ts) * TB) + wave * 2048)); \
        glds16(pol.kptr(kt_ * 64 + drow0) + kc0, dst_); glds16(pol.kptr(kt_ * 64 + drow1) + kc1, dst_ + 1024u); \
        glds16(pol.vptr(kt_ * 64 + drow0) + vc0, dst_ + VBASE); glds16(pol.vptr(kt_ * 64 + drow1) + vc1, dst_ + VBASE + 1024u); } } while (0)
    const int kbase = krow * 256;
    const int vq = qi >> 2, vp = qi & 3, vsw = (vq << 2) | ((rbq >> 2) & 3);
    const int vrowb = (rbq + vq) * 256 + 8 * (vp & 1), vph = vp >> 1;
    __syncthreads();
    ATT3_ISSUE(0);
    for (int it = 0; it < n_iter; ++it) {
        asm volatile("s_waitcnt vmcnt(0)" ::: "memory");
        __syncthreads();
        if (it + 1 < n_iter) ATT3_ISSUE(it + 1);
        const int kt = kt_lo + it * 2 + kgrp;
        if (kt < kt_hi && pol.wave_tile_active(kt)) {
            const LAS unsigned char* Kt = L + ((it & 1) * 2 + kgrp) * TB; const LAS unsigned char* Vt = Kt + VBASE;
            bf16x8 pf[NH][2];
#pragma unroll
            for (int h = 0; h < NH; ++h) {
                f32x4 s[4];
#pragma unroll
                for (int nt = 0; nt < 4; ++nt) { s[nt] = (f32x4){0.f, 0.f, 0.f, 0.f};
#pragma unroll
                    for (int ks = 0; ks < KS; ++ks) { const bf16x8 kf = *(const LAS bf16x8*)(Kt + nt * 4096 + kbase + (((ks * 4 + qg) ^ krow) * 16));
                        s[nt] = __builtin_amdgcn_mfma_f32_16x16x32_bf16(kf, qf[h][ks], s[nt], 0, 0, 0); } }
                float mx = NEGB;
#pragma unroll
                for (int nt = 0; nt < 4; ++nt)
#pragma unroll
                    for (int r = 0; r < 4; ++r) { const int k = kt * 64 + nt * 16 + rbq + r; const float v = pol.valid(iq, k) ? s[nt][r] * P::SC : NEGB; s[nt][r] = v; mx = fmaxf(mx, v); }
                mx = fmaxf(mx, __shfl_xor(mx, 16)); mx = fmaxf(mx, __shfl_xor(mx, 32));
                const float mnew = fmaxf(m[h], mx), msafe = mnew <= NEGB ? 0.f : mnew;
                const float corr = __builtin_amdgcn_exp2f(m[h] - msafe); m[h] = mnew;
                float psum = 0.f;
#pragma unroll
                for (int nt = 0; nt < 4; ++nt)
#pragma unroll
                    for (int r = 0; r < 4; ++r) { const float p = __builtin_amdgcn_exp2f(s[nt][r] - msafe); s[nt][r] = p; psum += p; }
                l[h] = l[h] * corr + psum;
#pragma unroll
                for (int dt = 0; dt < DT; ++dt) o[h][dt] *= corr;
#pragma unroll
                for (int i = 0; i < 2; ++i) { v4u w; w.x = pg8::cvt_pk_bf16(s[2 * i][0], s[2 * i][1]); w.y = pg8::cvt_pk_bf16(s[2 * i][2], s[2 * i][3]);
                    w.z = pg8::cvt_pk_bf16(s[2 * i + 1][0], s[2 * i + 1][1]); w.w = pg8::cvt_pk_bf16(s[2 * i + 1][2], s[2 * i + 1][3]); pf[h][i] = __builtin_bit_cast(bf16x8, w); }
            }
#pragma unroll
            for (int dt = 0; dt < DT; ++dt) { const LAS unsigned char* vrd = Vt + vrowb + ((((2 * dt) ^ (vsw & 14)) | (vph ^ (vsw & 1))) * 16);
#pragma unroll
                for (int i = 0; i < 2; ++i) {
                    const v4i16_t lo = __builtin_amdgcn_ds_read_tr16_b64_v4i16((LAS v4i16_t*)(vrd + i * 8192)), hi = __builtin_amdgcn_ds_read_tr16_b64_v4i16((LAS v4i16_t*)(vrd + i * 8192 + 4096));
                    const bf16x8 vf = (bf16x8){lo[0], lo[1], lo[2], lo[3], hi[0], hi[1], hi[2], hi[3]};
#pragma unroll
                    for (int h = 0; h < NH; ++h) o[h][dt] = __builtin_amdgcn_mfma_f32_16x16x32_bf16(vf, pf[h][i], o[h][dt], 0, 0, 0); } }
        }
    }
#undef ATT3_ISSUE
    {
        __syncthreads();
        LAS float* X = (LAS float*)L; constexpr int NV = DT * 4 + 2;
        if (kgrp == 1) {
#pragma unroll
            for (int h = 0; h < NH; ++h) { LAS float* xb = X + ((slab * NH + h) * NV) * 64 + lane; xb[0] = m[h]; xb[64] = l[h];
#pragma unroll
                for (int dt = 0; dt < DT; ++dt)
#pragma unroll
                    for (int r = 0; r < 4; ++r) xb[(2 + dt * 4 + r) * 64] = o[h][dt][r]; }
        }
        __syncthreads();
        if (kgrp == 0) {
#pragma unroll
            for (int h = 0; h < NH; ++h) { const LAS float* xb = X + ((slab * NH + h) * NV) * 64 + lane; const float mb = xb[0], lb = xb[64];
                const float mn = fmaxf(m[h], mb), ms = mn <= NEGB ? 0.f : mn; const float fa = __builtin_amdgcn_exp2f(m[h] - ms), fb = __builtin_amdgcn_exp2f(mb - ms);
                m[h] = mn; l[h] = l[h] * fa + lb * fb;
#pragma unroll
                for (int dt = 0; dt < DT; ++dt)
#pragma unroll
                    for (int r = 0; r < 4; ++r) o[h][dt][r] = o[h][dt][r] * fa + xb[(2 + dt * 4 + r) * 64] * fb; }
        }
    }
    if (kgrp == 0) {
#pragma unroll
        for (int h = 0; h < NH; ++h) { float lt = l[h]; lt += __shfl_xor(lt, 16); lt += __shfl_xor(lt, 32); const float inv = 1.0f / lt;
            if (qg == 0) pol.stats(iq, h, m[h], lt);
#pragma unroll
            for (int dt = 0; dt < DT; ++dt) pol.out4(iq, h, dt * 16 + qg * 4, o[h][dt] * inv); }
    }
    __syncthreads();
}

constexpr float SC128 = 0.08838834764831845f * 1.4426950408889634f, SC64 = 0.125f * 1.4426950408889634f, LN2 = 0.6931471805599453f;
struct SlcPol {
    static constexpr float SC = SC128;
    const bf16* COLS; const float* OC; const float* OW; bf16* BR; int b, g, qt, h0, kt_lo, kt_hi; unsigned mask; float gate[3];
    __device__ __forceinline__ void init(unsigned char* ws, int b_, int g_, int qt_, int iq, int h0_ = 0) { h0 = h0_;
        COLS = (const bf16*)(ws + WS_COLS); OC = (const float*)(ws + WS_OC); OW = (const float*)(ws + WS_OW); BR = (bf16*)(ws + WS_BR); b = b_; g = g_; qt = qt_; kt_lo = 0; kt_hi = qt_ + 1;
        const int row = b * SEQ + qt * 64 + iq; mask = ((const unsigned*)(ws + WS_SEL))[row * 2 + g];
#pragma unroll
        for (int h = 0; h < 3; ++h) gate[h] = bf2f(COLS[(size_t)row * NCOLS + C_GC + (g * 3 + (h + h0_ > 2 ? 2 : h + h0_)) * 3 + 1]);
    }
    __device__ __forceinline__ const bf16* qptr(int iq, int h) const { return COLS + (size_t)(b * SEQ + qt * 64 + iq) * NCOLS + C_QC + (g * 3 + h0 + h) * 128; }
    __device__ __forceinline__ const bf16* kptr(int k) const { return COLS + (size_t)(b * SEQ + k) * NCOLS + C_KSLC + g * 128; }
    __device__ __forceinline__ const bf16* vptr(int k) const { return COLS + (size_t)(b * SEQ + k) * NCOLS + C_VSLC + g * 128; }
    __device__ __forceinline__ bool wave_tile_active(int kt) const { return __any((int)((mask >> kt) & 1u)) != 0; }
    __device__ __forceinline__ bool valid(int iq, int k) const { return ((mask >> (k >> 6)) & 1u) && k <= qt * 64 + iq; }
    __device__ __forceinline__ void stats(int, int, float, float) const {}
    __device__ __forceinline__ void out4(int iq, int h, int d, f32x4 v) const {
        const size_t off = (size_t)(b * SEQ + qt * 64 + iq) * 768 + (g * 3 + h0 + h) * 128 + d; const f32x4 c = *(const f32x4*)(OC + off), w = *(const f32x4*)(OW + off); const f32x4 t = c + w + v * gate[h];
        *(unsigned long long*)(BR + (size_t)(b * SEQ + qt * 64 + iq) * NBR + 768 + (g * 3 + h0 + h) * 128 + d) = (unsigned long long)pk2(t.x, t.y) | ((unsigned long long)pk2(t.z, t.w) << 32);
    }
};
struct WinPol {
    static constexpr float SC = SC128;
    const bf16* COLS; float* OW; int b, g, qt, h0, kt_lo, kt_hi; float gate[3];
    __device__ __forceinline__ void init(unsigned char* ws, int b_, int g_, int qt_, int iq, int h0_ = 0) { h0 = h0_;
        COLS = (const bf16*)(ws + WS_COLS); OW = (float*)(ws + WS_OW); b = b_; g = g_; qt = qt_; kt_lo = qt_ > 8 ? qt_ - 8 : 0; kt_hi = qt_ + 1;
        const int row = b * SEQ + qt * 64 + iq;
#pragma unroll
        for (int h = 0; h < 3; ++h) gate[h] = bf2f(COLS[(size_t)row * NCOLS + C_GC + (g * 3 + (h + h0_ > 2 ? 2 : h + h0_)) * 3 + 2]);
    }
    __device__ __forceinline__ const bf16* qptr(int iq, int h) const { return COLS + (size_t)(b * SEQ + qt * 64 + iq) * NCOLS + C_QC + (g * 3 + h0 + h) * 128; }
    __device__ __forceinline__ const bf16* kptr(int k) const { return COLS + (size_t)(b * SEQ + k) * NCOLS + C_KWIN + g * 128; }
    __device__ __forceinline__ const bf16* vptr(int k) const { return COLS + (size_t)(b * SEQ + k) * NCOLS + C_VWIN + g * 128; }
    __device__ __forceinline__ bool wave_tile_active(int) const { return true; }
    __device__ __forceinline__ bool valid(int iq, int k) const { const int t = qt * 64 + iq; return k <= t && k > t - 512; }
    __device__ __forceinline__ void stats(int, int, float, float) const {}
    __device__ __forceinline__ void out4(int iq, int h, int d, f32x4 v) const { *(f32x4*)(OW + (size_t)(b * SEQ + qt * 64 + iq) * 768 + (g * 3 + h0 + h) * 128 + d) = v * gate[h]; }
};
struct DilPol {
    static constexpr float SC = SC64;
    const bf16* COLS; float* OG; float* LSE; int b, gi, hh, r, qb, dil, kt_lo, kt_hi;
    __device__ __forceinline__ void init(unsigned char* ws, int b_, int gi_, int h_, int r_, int qb_) {
        COLS = (const bf16*)(ws + WS_COLS); OG = (float*)(ws + WS_OG); LSE = (float*)(ws + WS_LSE); b = b_; gi = gi_; hh = h_; r = r_; qb = qb_; dil = 1 << (2 * gi_);
        const int nt = (SEQ / dil) / 64; kt_lo = 2 * qb_ - 2 > 0 ? 2 * qb_ - 2 : 0; kt_hi = 2 * qb_ + 2 < nt ? 2 * qb_ + 2 : nt;
    }
    __device__ __forceinline__ int row(int iq) const { return b * SEQ + r + (qb * 128 + iq) * dil; }
    __device__ __forceinline__ const bf16* qptr(int iq, int) const { return COLS + (size_t)row(iq) * NCOLS + C_QA + (gi * 4 + hh) * 64; }
    __device__ __forceinline__ const bf16* kptr(int k) const { return COLS + (size_t)(b * SEQ + r + k * dil) * NCOLS + C_KA + (gi * 4 + hh) * 64; }
    __device__ __forceinline__ const bf16* vptr(int k) const { return COLS + (size_t)(b * SEQ + r + k * dil) * NCOLS + C_VA + (gi * 4 + hh) * 64; }
    __device__ __forceinline__ bool wave_tile_active(int) const { return true; }
    __device__ __forceinline__ bool valid(int iq, int k) const { const int i = qb * 128 + iq; return k <= i && k >= i - 128; }
    __device__ __forceinline__ void stats(int iq, int, float mm, float lt) const { LSE[((size_t)gi * MTOK + row(iq)) * 4 + hh] = mm * LN2 + __logf(lt); }
    __device__ __forceinline__ void out4(int iq, int, int d, f32x4 v) const { *(f32x4*)(OG + ((size_t)gi * MTOK + row(iq)) * 256 + hh * 64 + d) = v; }
};
}

namespace mixu {
using att::bf16x8; using att::KP; using att::VP;
__device__ __forceinline__ float gelu_tanh_f(float x) { const float y = 0.7978845608028654f * (x + 0.044715f * x * x * x); const float t = 1.0f - 2.0f / (1.0f + __expf(2.0f * y)); return 0.5f * x * (1.0f + t); }

__device__ __forceinline__ void compress_unit(const Frame& F, unsigned char* ws, int l, int unit, const float* pe_k, const float* pe_v) {
    const int kv = unit & 1, cch = (unit >> 1) & 7, bg = unit >> 4, b = bg >> 1, g = bg & 1, c0 = cch * 16;
    const bf16* COLS = (const bf16*)(ws + WS_COLS); unsigned char* wl = ws + WS_W + (size_t)l * W_LAYER;
    const bf16* W1T = (const bf16*)(wl + (kv ? WO_C1V : WO_C1K)); const bf16* W2T = (const bf16*)(wl + (kv ? WO_C2V : WO_C2K)); const float* pe = kv ? pe_v : pe_k;
    const int lane = F.lane, w = F.wave, qi = lane & 15, qg = lane >> 4, col0 = (kv ? C_VCMP : C_KCMP) + g * 128;
    int cc = c0 + qi; cc = cc > 126 ? 126 : cc;
    const bf16* xrow = COLS + (size_t)(b * SEQ + 16 * cc) * NCOLS + col0;
    f32x4 acc[8];
#pragma unroll
    for (int nt = 0; nt < 8; ++nt) acc[nt] = (f32x4){0.f, 0.f, 0.f, 0.f};
#pragma unroll 4
    for (int ks = 0; ks < 16; ++ks) { const int k = w * 512 + ks * 32 + qg * 8, j = k >> 7, d = k & 127;
        float x[8]; load8(xrow + (size_t)j * NCOLS + d, x); const f32x4 p0 = *(const f32x4*)(pe + k), p1 = *(const f32x4*)(pe + k + 4);
        v4u xw; xw.x = pg8::cvt_pk_bf16(x[0] + p0.x, x[1] + p0.y); xw.y = pg8::cvt_pk_bf16(x[2] + p0.z, x[3] + p0.w); xw.z = pg8::cvt_pk_bf16(x[4] + p1.x, x[5] + p1.y); xw.w = pg8::cvt_pk_bf16(x[6] + p1.z, x[7] + p1.w);
        const bf16x8 xb = __builtin_bit_cast(bf16x8, xw);
#pragma unroll
        for (int nt = 0; nt < 8; ++nt) { const bf16x8 wf = *(const bf16x8*)(W1T + (size_t)(nt * 16 + qi) * 4096 + k); acc[nt] = __builtin_amdgcn_mfma_f32_16x16x32_bf16(wf, xb, acc[nt], 0, 0, 0); } }
    LAS float* Pp = (LAS float*)(F.lds + RING_OFF);
    LAS unsigned char* G = F.lds + RING_OFF + 65536;
    __syncthreads();
#pragma unroll
    for (int nt = 0; nt < 8; ++nt)
#pragma unroll
        for (int r = 0; r < 4; ++r) Pp[(w * 128 + nt * 16 + 4 * qg + r) * 16 + qi] = acc[nt][r];
    __syncthreads();
#pragma unroll
    for (int j = 0; j < 4; ++j) { const int e = F.tid + 512 * j, n = e >> 4, c = e & 15; float s = 0.f;
#pragma unroll
        for (int ww = 0; ww < 8; ++ww) s += Pp[(ww * 128 + n) * 16 + c];
        *(LAS unsigned short*)(G + c * KP + n * 2) = (unsigned short)f2bf(gelu_tanh_f(s)); }
    __syncthreads();
    f32x4 o = {0.f, 0.f, 0.f, 0.f};
#pragma unroll
    for (int ks = 0; ks < 4; ++ks) { const bf16x8 wf = *(const bf16x8*)(W2T + (size_t)(w * 16 + qi) * 128 + ks * 32 + qg * 8); const bf16x8 gf = *(const LAS bf16x8*)(G + qi * KP + (ks * 32 + qg * 8) * 2);
        o = __builtin_amdgcn_mfma_f32_16x16x32_bf16(wf, gf, o, 0, 0, 0); }
    bf16* dst = (bf16*)(ws + (kv ? WS_VC : WS_KC)) + (size_t)(bg * 128 + c0 + qi) * 128 + w * 16 + 4 * qg;
    const bool real = c0 + qi < 127;
    *(unsigned long long*)dst = real ? ((unsigned long long)pk2(o[0], o[1]) | ((unsigned long long)pk2(o[2], o[3]) << 32)) : 0ull;
    __syncthreads();
}

template <int GI>
__device__ __forceinline__ void pool_unit_t(const Frame& F, unsigned char* ws, int l, int blk, const float* pscale) {
    constexpr int WIN = 2 << GI;
    int tid_l = F.tid; asm volatile("" : "+v"(tid_l));
    const int lane = tid_l & 63, w = __builtin_amdgcn_readfirstlane(tid_l >> 6), qi = lane & 15, qg = lane >> 4;
    const bf16* COLS = (const bf16*)(ws + WS_COLS); const bf16* PT = (const bf16*)(ws + WS_W + (size_t)l * W_LAYER + WO_POOL) + GI * 16384;
    const int row = blk * 32 + (w >> 2) * 16 + qi, s = row & (SEQ - 1); const int cnt = s + 1 < WIN ? s + 1 : WIN; const float rc = 1.0f / (float)cnt;
    const bf16* xr = COLS + (size_t)row * NCOLS + C_XB + GI * 128;
    f32x4 acc[8];
#pragma unroll
    for (int nt = 0; nt < 8; ++nt) acc[nt] = (f32x4){0.f, 0.f, 0.f, 0.f};
#pragma unroll
    for (int ks = 0; ks < 4; ++ks) { const int c = ks * 32 + qg * 8; v4u xw[WIN];
#pragma unroll
        for (int j = 0; j < WIN; ++j) xw[j] = *(const v4u*)(xr - (ptrdiff_t)(j < cnt ? j : 0) * NCOLS + c);
        float sum[8];
#pragma unroll
        for (int e = 0; e < 8; ++e) sum[e] = 0.f;
#pragma unroll
        for (int j = 0; j < WIN; ++j) { const float mk = j < cnt ? 1.f : 0.f; const v4u q = xw[j];
            sum[0] += mk * pg8::bflo(q.x); sum[1] += mk * pg8::bfhi(q.x); sum[2] += mk * pg8::bflo(q.y); sum[3] += mk * pg8::bfhi(q.y);
            sum[4] += mk * pg8::bflo(q.z); sum[5] += mk * pg8::bfhi(q.z); sum[6] += mk * pg8::bflo(q.w); sum[7] += mk * pg8::bfhi(q.w); }
        const v4u q0 = xw[0];
        v4u pw; pw.x = pg8::cvt_pk_bf16(sum[0] * rc - pg8::bflo(q0.x), sum[1] * rc - pg8::bfhi(q0.x)); pw.y = pg8::cvt_pk_bf16(sum[2] * rc - pg8::bflo(q0.y), sum[3] * rc - pg8::bfhi(q0.y));
        pw.z = pg8::cvt_pk_bf16(sum[4] * rc - pg8::bflo(q0.z), sum[5] * rc - pg8::bfhi(q0.z)); pw.w = pg8::cvt_pk_bf16(sum[6] * rc - pg8::bflo(q0.w), sum[7] * rc - pg8::bfhi(q0.w));
        const bf16x8 pb = __builtin_bit_cast(bf16x8, pw);
#pragma unroll
        for (int nt = 0; nt < 8; ++nt) { const bf16x8 wf = *(const bf16x8*)(PT + (size_t)(nt * 16 + qi) * 128 + c); acc[nt] = __builtin_amdgcn_mfma_f32_16x16x32_bf16(wf, pb, acc[nt], 0, 0, 0); } }
    bf16* dst = (bf16*)(ws + WS_BR) + (size_t)row * NBR + 256 + GI * 128 + 4 * qg;
#pragma unroll
    for (int nt = 0; nt < 8; ++nt) { const f32x4 sc = *(const f32x4*)(pscale + GI * 128 + nt * 16 + 4 * qg); const f32x4 v = acc[nt] * sc;
        *(unsigned long long*)(dst + nt * 16) = (unsigned long long)pk2(v.x, v.y) | ((unsigned long long)pk2(v.z, v.w) << 32); }
}
__device__ __forceinline__ void pool_unit(const Frame& F, unsigned char* ws, int l, int unit, const float* pscale) {
    const int gi = F.wave & 3, blk = unit;
    if (gi == 0) pool_unit_t<0>(F, ws, l, blk, pscale); else if (gi == 1) pool_unit_t<1>(F, ws, l, blk, pscale); else if (gi == 2) pool_unit_t<2>(F, ws, l, blk, pscale); else pool_unit_t<3>(F, ws, l, blk, pscale);
}

__device__ __forceinline__ void cmp_unit(const Frame& F, unsigned char* ws, int unit) {
    constexpr int KBYTES = 64 * KP, TILE = att::tile_bytes(128), SCO = 2 * TILE;
    static_assert(SCO + 128 * 33 * 4 <= RING_BYTES, "cmp unit LDS");
    const int qb = unit & 15, bg = unit >> 4, b = bg >> 1, g = bg & 1;
    const bf16* COLS = (const bf16*)(ws + WS_COLS); const bf16* KC = (const bf16*)(ws + WS_KC) + (size_t)bg * 16384; const bf16* VC = (const bf16*)(ws + WS_VC) + (size_t)bg * 16384;
    float* OC = (float*)(ws + WS_OC); unsigned* SEL = (unsigned*)(ws + WS_SEL);
    LAS unsigned char* const L = F.lds + RING_OFF;
    const int tid = F.tid, lane = F.lane, w = F.wave, qi = lane & 15, qg = lane >> 4, iq = w * 16 + qi, t = qb * 128 + iq, row = b * SEQ + t;
    __syncthreads();
    {
        const int vkp = tid & 31, vdc = tid >> 5;
#pragma unroll
        for (int ts = 0; ts < 2; ++ts) { LAS unsigned char* base = L + ts * TILE;
#pragma unroll
            for (int c = 0; c < 2; ++c) { const int ch = tid + 512 * c; *(LAS v4u*)(base + (ch >> 4) * KP + (ch & 15) * 16) = *(const v4u*)(KC + (size_t)(ts * 64 + (ch >> 4)) * 128 + (ch & 15) * 8); }
            const v4u a = *(const v4u*)(VC + (size_t)(ts * 64 + 2 * vkp) * 128 + vdc * 8), bb = *(const v4u*)(VC + (size_t)(ts * 64 + 2 * vkp + 1) * 128 + vdc * 8);
            LAS unsigned char* vb = base + KBYTES + (vdc * 8) * VP + att::slotpos(2 * vkp) * 2;
            *(LAS unsigned*)(vb + 0 * VP) = (a.x & 0xffffu) | (bb.x << 16); *(LAS unsigned*)(vb + 1 * VP) = (a.x >> 16) | (bb.x & 0xffff0000u);
            *(LAS unsigned*)(vb + 2 * VP) = (a.y & 0xffffu) | (bb.y << 16); *(LAS unsigned*)(vb + 3 * VP) = (a.y >> 16) | (bb.y & 0xffff0000u);
            *(LAS unsigned*)(vb + 4 * VP) = (a.z & 0xffffu) | (bb.z << 16); *(LAS unsigned*)(vb + 5 * VP) = (a.z >> 16) | (bb.z & 0xffff0000u);
            *(LAS unsigned*)(vb + 6 * VP) = (a.w & 0xffffu) | (bb.w << 16); *(LAS unsigned*)(vb + 7 * VP) = (a.w >> 16) | (bb.w & 0xffff0000u); }
    }
    __syncthreads();
    f32x4 ph[2][4];
#pragma unroll
    for (int ts = 0; ts < 2; ++ts)
#pragma unroll
        for (int nt = 0; nt < 4; ++nt) ph[ts][nt] = (f32x4){0.f, 0.f, 0.f, 0.f};
#pragma unroll 1
    for (int h = 0; h < 3; ++h) {
        bf16x8 qf[4];
#pragma unroll
        for (int ks = 0; ks < 4; ++ks) qf[ks] = *(const bf16x8*)(COLS + (size_t)row * NCOLS + C_QC + (g * 3 + h) * 128 + ks * 32 + qg * 8);
        f32x4 s[2][4]; float mx = att::NEGB;
#pragma unroll
        for (int ts = 0; ts < 2; ++ts)
#pragma unroll
            for (int nt = 0; nt < 4; ++nt) { s[ts][nt] = (f32x4){0.f, 0.f, 0.f, 0.f};
#pragma unroll
                for (int ks = 0; ks < 4; ++ks) { const bf16x8 kf = *(const LAS bf16x8*)(L + ts * TILE + (nt * 16 + qi) * KP + (ks * 32 + qg * 8) * 2); s[ts][nt] = __builtin_amdgcn_mfma_f32_16x16x32_bf16(kf, qf[ks], s[ts][nt], 0, 0, 0); }
#pragma unroll
                for (int r = 0; r < 4; ++r) { const int c = ts * 64 + nt * 16 + qg * 4 + r; const float v = (c * 16 + 31 <= t && c <= 126) ? s[ts][nt][r] * att::SC128 : att::NEGB; s[ts][nt][r] = v; mx = fmaxf(mx, v); } }
        mx = fmaxf(mx, __shfl_xor(mx, 16)); mx = fmaxf(mx, __shfl_xor(mx, 32));
        const float msafe = mx <= att::NEGB ? 0.f : mx; float psum = 0.f;
#pragma unroll
        for (int ts = 0; ts < 2; ++ts)
#pragma unroll
            for (int nt = 0; nt < 4; ++nt)
#pragma unroll
                for (int r = 0; r < 4; ++r) { const float p = __builtin_amdgcn_exp2f(s[ts][nt][r] - msafe); s[ts][nt][r] = p; psum += p; }
        psum += __shfl_xor(psum, 16); psum += __shfl_xor(psum, 32);
        const float inv = psum > 0.f ? 1.0f / psum : 0.f;
        f32x4 o[8];
#pragma unroll
        for (int dt = 0; dt < 8; ++dt) o[dt] = (f32x4){0.f, 0.f, 0.f, 0.f};
#pragma unroll
        for (int ts = 0; ts < 2; ++ts) {
#pragma unroll
            for (int nt = 0; nt < 4; ++nt) { s[ts][nt] *= inv; ph[ts][nt] += s[ts][nt]; }
#pragma unroll
            for (int i = 0; i < 2; ++i) { v4u pw; pw.x = pg8::cvt_pk_bf16(s[ts][2 * i][0], s[ts][2 * i][1]); pw.y = pg8::cvt_pk_bf16(s[ts][2 * i][2], s[ts][2 * i][3]);
                pw.z = pg8::cvt_pk_bf16(s[ts][2 * i + 1][0], s[ts][2 * i + 1][1]); pw.w = pg8::cvt_pk_bf16(s[ts][2 * i + 1][2], s[ts][2 * i + 1][3]); const bf16x8 pf = __builtin_bit_cast(bf16x8, pw);
#pragma unroll
                for (int dt = 0; dt < 8; ++dt) { const bf16x8 vf = *(const LAS bf16x8*)(L + ts * TILE + KBYTES + (dt * 16 + qi) * VP + (i * 32 + qg * 8) * 2); o[dt] = __builtin_amdgcn_mfma_f32_16x16x32_bf16(vf, pf, o[dt], 0, 0, 0); } } }
        const float gate = bf2f(COLS[(size_t)row * NCOLS + C_GC + (g * 3 + h) * 3 + 0]);
#pragma unroll
        for (int dt = 0; dt < 8; ++dt) *(f32x4*)(OC + (size_t)row * 768 + (g * 3 + h) * 128 + dt * 16 + qg * 4) = o[dt] * gate;
    }
    float imp[2][4], y[2][4];
#pragma unroll
    for (int ts = 0; ts < 2; ++ts)
#pragma unroll
        for (int nt = 0; nt < 4; ++nt) { imp[ts][nt] = (ph[ts][nt][0] + ph[ts][nt][1]) + (ph[ts][nt][2] + ph[ts][nt][3]); y[ts][nt] = __shfl(ph[ts][nt][3], (lane + 48) & 63); }
    LAS float* SC = (LAS float*)(L + SCO) + iq * 33; const int tb = t >> 6;
#pragma unroll
    for (int ts = 0; ts < 2; ++ts)
#pragma unroll
        for (int nt = 0; nt < 4; ++nt) { const float yp = nt > 0 ? y[ts][nt - 1] : (ts > 0 ? y[ts - 1][3] : 0.f); const float prev = qg > 0 ? y[ts][nt] : yp;
            const int j = 16 * ts + 4 * nt + qg; const bool forced = (j == 0) || (j == tb) || (j == tb - 1);
            const float sc = j > tb ? -1.0f : (imp[ts][nt] + prev) + (forced ? 100.0f : 0.0f); imp[ts][nt] = sc; SC[j] = sc; }
    LDS_WAIT(); asm volatile("" ::: "memory");
    unsigned bits = 0u;
    int rank[2][4];
#pragma unroll
    for (int ts = 0; ts < 2; ++ts)
#pragma unroll
        for (int nt = 0; nt < 4; ++nt) rank[ts][nt] = 0;
    for (int i = 0; i < 32; ++i) { const float si = SC[i];
#pragma unroll
        for (int ts = 0; ts < 2; ++ts)
#pragma unroll
            for (int nt = 0; nt < 4; ++nt) { const int j = 16 * ts + 4 * nt + qg; rank[ts][nt] += (si > imp[ts][nt] || (si == imp[ts][nt] && i < j)) ? 1 : 0; } }
#pragma unroll
    for (int ts = 0; ts < 2; ++ts)
#pragma unroll
        for (int nt = 0; nt < 4; ++nt) if (rank[ts][nt] < 8) bits |= 1u << (16 * ts + 4 * nt + qg);
    bits |= (unsigned)__shfl_xor((int)bits, 16); bits |= (unsigned)__shfl_xor((int)bits, 32);
    if (qg == 0) SEL[row * 2 + g] = bits;
    __syncthreads();
}
}
__device__ __forceinline__ void mix_phase_a(const Frame& F, int l) {
    unsigned char* ws = ws_ptr(F);
    const bf16* COLS = (const bf16*)(ws + WS_COLS);
    const int lane = F.lane;
    for (int rep = 0; rep < 1 + ((PROBE_SUB >> 0) & 1); ++rep)
    for (int j = 0; j < 256; ++j) {
        int u; if (F.G == 256) { if (j > 1 || F.bx >= 128) break; u = F.bx + 128 * j; } else { u = F.bx + j * F.G; if (u >= 256) break; }
        att::WinPol pol; pol.init(ws, u >> 6, (u >> 5) & 1, u & 31, (F.wave & 3) * 16 + (lane & 15), 0); att::attn_unit3<2>(F, pol); }
    for (int rep = 0; rep < 1 + ((PROBE_SUB >> 1) & 1); ++rep)
    for (int u = F.bx; u < 768; u += F.G) { const int gi = u >> 8, v = u & 255, rest = v & 15; att::DilPol pol;
        pol.init(ws, v >> 6, gi, (v >> 4) & 3, gi == 0 ? 0 : (gi == 1 ? rest >> 2 : rest), gi == 0 ? rest : (gi == 1 ? rest & 3 : 0)); att::attn_unit<64, 1, 1>(F, pol); }
    { const float* pek = in_ptr(F, 8) + (size_t)l * 4096; const float* pev = in_ptr(F, 11) + (size_t)l * 4096;
      for (int rep = 0; rep < 1 + ((PROBE_SUB >> 2) & 1); ++rep)
      for (int u = F.bx; u < 256; u += F.G) { const int uu = (u + 128) & 255; if (uu < 128) mixu::compress_unit(F, ws, l, uu, pek, pev); } }
    { const float* psc = in_ptr(F, 7) + (size_t)l * 512; for (int rep = 0; rep < 1 + ((PROBE_SUB >> 3) & 1); ++rep) for (int u = F.bx; u < 256; u += F.G) mixu::pool_unit(F, ws, l, u, psc); }
}

__device__ __forceinline__ void mix_phase_b(const Frame& F) {
    unsigned char* ws = ws_ptr(F); const int lane = F.lane;
    for (int j = 0; j < 128; ++j) { int u; if (F.G == 256) { if (j > 0 || F.bx >= 128) break; u = F.bx; } else { u = F.bx + j * F.G; if (u >= 128) break; } mixu::cmp_unit(F, ws, u); }
    for (int j = 0; j < 256; ++j) { int u; if (F.G == 256) { if (j > 1 || F.bx < 128) break; u = (F.bx - 128) + 128 * j; } else { u = F.bx + j * F.G; if (u >= 256) break; }
        att::WinPol pol; pol.init(ws, u >> 6, (u >> 5) & 1, u & 31, (F.wave & 3) * 16 + (lane & 15), 2); att::attn_unit3<1>(F, pol); }
    {
        const float* OG = (const float*)(ws + WS_OG); const float* LSE = (const float*)(ws + WS_LSE); bf16* BR = (bf16*)(ws + WS_BR);
        const bool half = F.G == 256; const int gw = half ? (F.bx - 128) * NWAVES + F.wave : F.bx * NWAVES + F.wave, ngw = half ? 128 * NWAVES : F.G * NWAVES;
        if (!half || F.bx >= 128)
        for (int row = gw; row < MTOK; row += ngw) {
            const int h = lane >> 4;
            const float l0 = LSE[((size_t)0 * MTOK + row) * 4 + h], l1 = LSE[((size_t)1 * MTOK + row) * 4 + h], l2 = LSE[((size_t)2 * MTOK + row) * 4 + h];
            const float mx = fmaxf(l0, fmaxf(l1, l2)); float w0 = __expf(l0 - mx), w1 = __expf(l1 - mx), w2 = __expf(l2 - mx); const float inv = 1.0f / (w0 + w1 + w2); w0 *= inv; w1 *= inv; w2 *= inv;
            const f32x4 a0 = *(const f32x4*)(OG + ((size_t)0 * MTOK + row) * 256 + lane * 4), a1 = *(const f32x4*)(OG + ((size_t)1 * MTOK + row) * 256 + lane * 4), a2 = *(const f32x4*)(OG + ((size_t)2 * MTOK + row) * 256 + lane * 4);
            const f32x4 o = a0 * w0 + a1 * w1 + a2 * w2;
            *(unsigned long long*)(BR + (size_t)row * NBR + lane * 4) = (unsigned long long)pk2(o.x, o.y) | ((unsigned long long)pk2(o.z, o.w) << 32);
        }
    }
}

__device__ __forceinline__ void mix_phase_c(const Frame& F) {
    unsigned char* ws = ws_ptr(F);
    const bf16* COLS = (const bf16*)(ws + WS_COLS); const float* OC = (const float*)(ws + WS_OC); const float* OW = (const float*)(ws + WS_OW);
    const unsigned* SEL = (const unsigned*)(ws + WS_SEL); bf16* BR = (bf16*)(ws + WS_BR);
    const int lane = F.lane;
    for (int u = F.bx; u < 512; u += F.G) { const int v = u & 255; att::SlcPol pol; pol.init(ws, (v & 7) >> 1, v & 1, u < 256 ? 31 - (v >> 3) : (v >> 3), (F.wave & 3) * 16 + (lane & 15), u < 256 ? 0 : 2); if (u < 256) att::attn_unit3<2>(F, pol); else att::attn_unit3<1>(F, pol); }
}

#ifndef PROBE_TWICE_MASK
#define PROBE_TWICE_MASK 0
#endif
#define PH_SITE(site, ...) if (ph >= lo && ph < hi) { { const Frame F = make_frame(ldsp, nullptr); __VA_ARGS__ if (ph + 1 < hi || ((PROBE_TWICE_MASK >> (site)) & 1)) { xcd_barrier(bar); if (PROBE_BAR2) xcd_barrier(bar); } } \
        if ((PROBE_TWICE_MASK >> (site)) & 1) { const Frame F = make_frame(ldsp, nullptr); __VA_ARGS__ if (ph + 1 < hi) xcd_barrier(bar); } } ++ph;
#define WSP(off) (ws_ptr(F) + (off))
template <int l> __device__ __forceinline__ void layer_phases(LAS unsigned char* const ldsp, const int lo, const int hi, int& ph, const XcdBarrier& bar) {
        PH_SITE(1,
        { unsigned char* ws = ws_ptr(F); unsigned char* wl = ws + WS_W + (size_t)l * W_LAYER;
          pg8::Gemm g{(const bf16*)(ws + WS_XN), (const bf16*)(wl + WO_WI1), MTOK, 2 * DFF, DM, DM, DM}; pg8::StaticOrder S; S.init(MTOK, 2 * DFF, F.G, F.bx);
          pg8::EpiSwiglu E{(bf16*)(ws + WS_H), DFF}; pg8::gemm_phase<pg8::EpiSwiglu, pg8::StaticOrder, true, true>(F.lds + RING_OFF, g, S, E);
          if (MK_FILLER) tr_filler(F, TR_PRO + l * FILL_L, FILL_A, (32 * 44) % 256); }
        )
        PH_SITE(2,
        { unsigned char* ws = ws_ptr(F); unsigned char* wl = ws + WS_W + (size_t)l * W_LAYER; float* X = out_ptr(F);
          pg8::Gemm g{(const bf16*)(ws + WS_H), (const bf16*)(wl + WO_WO1), MTOK, DM, DFF, DFF, DFF}; pg8::StaticOrder S; S.init(MTOK, DM, F.G, F.bx);
          pg8::EpiRes E{l == 0 ? in_ptr(F, 0) : X, X, DM, 0.5f}; pg8::gemm_phase<pg8::EpiRes, pg8::StaticOrder, true, true>(F.lds + RING_OFF, g, S, E); }
        )
        PH_SITE(3,
        rmsnorm_rows_bf16(F, out_ptr(F), in_ptr(F, 4) + (size_t)l * DM, (bf16*)WSP(WS_XN));
        )
        PH_SITE(4,
        { unsigned char* ws = ws_ptr(F); unsigned char* wl = ws + WS_W + (size_t)l * W_LAYER;
          pg8::Gemm g{(const bf16*)(ws + WS_XN), (const bf16*)(wl + WO_WIN), MTOK, NCOLS, DM, DM, DM}; pg8::StaticOrder S; S.init(MTOK, NCOLS, F.G, F.bx);
          pg8::EpiCols E{(bf16*)(ws + WS_COLS), NCOLS, SIG_TILE}; pg8::gemm_phase<pg8::EpiCols, pg8::StaticOrder, true, true>(F.lds + RING_OFF, g, S, E);
          if (MK_FILLER) tr_filler(F, TR_PRO + l * FILL_L + FILL_A, FILL_B, (32 * 45) % 256); }
        )
        PH_SITE(5,
        mix_phase_a(F, l);
        )
        PH_SITE(6,
        mix_phase_b(F);
        )
        PH_SITE(7,
        mix_phase_c(F);
        )
        PH_SITE(8,
        { unsigned char* ws = ws_ptr(F); unsigned char* wl = ws + WS_W + (size_t)l * W_LAYER;
          const bf16* BR = (const bf16*)(ws + WS_BR); const bf16* PT = (const bf16*)(wl + WO_PROJ); const bf16* GM = (const bf16*)(ws + WS_COLS) + C_GM; float* ZF = (float*)(ws + WS_ZF); bf16* Z = (bf16*)(ws + WS_Z);
          pg8::StaticOrder S; S.init(MTOK, DM, F.G, F.bx);
          { pg8::Gemm g{BR, PT, MTOK, DM, NBR, NBR, NBR}; pg8::EpiProjF E{GM, NCOLS, Z, DM, 4, 12}; pg8::gemm_phase<pg8::EpiProjF, pg8::StaticOrder, true, true>(F.lds + RING_OFF, g, S, E); }
        }
        )
        PH_SITE(9,
        { unsigned char* ws = ws_ptr(F); unsigned char* wl = ws + WS_W + (size_t)l * W_LAYER; float* X = out_ptr(F);
          pg8::Gemm g{(const bf16*)(ws + WS_Z), (const bf16*)(wl + WO_WOUT), MTOK, DM, DM, DM, DM}; pg8::StaticOrder S; S.init(MTOK, DM, F.G, F.bx);
          pg8::EpiRes E{X, X, DM, 1.0f}; pg8::gemm_phase<pg8::EpiRes, pg8::StaticOrder, true, true>(F.lds + RING_OFF, g, S, E); }
        )
        PH_SITE(10,
        rmsnorm_rows_bf16(F, out_ptr(F), in_ptr(F, 18) + (size_t)l * DM, (bf16*)WSP(WS_XN));
        )
        PH_SITE(11,
        { unsigned char* ws = ws_ptr(F); unsigned char* wl = ws + WS_W + (size_t)l * W_LAYER;
          pg8::Gemm g{(const bf16*)(ws + WS_XN), (const bf16*)(wl + WO_WI2), MTOK, 2 * DFF, DM, DM, DM}; pg8::StaticOrder S; S.init(MTOK, 2 * DFF, F.G, F.bx);
          pg8::EpiSwiglu E{(bf16*)(ws + WS_H), DFF}; pg8::gemm_phase<pg8::EpiSwiglu, pg8::StaticOrder, true, true>(F.lds + RING_OFF, g, S, E);
          if (MK_FILLER) tr_filler(F, TR_PRO + l * FILL_L + FILL_A + FILL_B, FILL_C, (32 * 44) % 256); }
        )
        PH_SITE(12,
        { unsigned char* ws = ws_ptr(F); unsigned char* wl = ws + WS_W + (size_t)l * W_LAYER; float* X = out_ptr(F);
          pg8::Gemm g{(const bf16*)(ws + WS_H), (const bf16*)(wl + WO_WO2), MTOK, DM, DFF, DFF, DFF}; pg8::StaticOrder S; S.init(MTOK, DM, F.G, F.bx);
          pg8::EpiRes E{X, X, DM, 0.5f}; pg8::gemm_phase<pg8::EpiRes, pg8::StaticOrder, true, true>(F.lds + RING_OFF, g, S, E); }
        )
        PH_SITE(13,
        if (l + 1 < DEPTH) rmsnorm_rows_bf16(F, out_ptr(F), in_ptr(F, 1) + (size_t)(l + 1) * DM, (bf16*)WSP(WS_XN));
        else rmsnorm_rows_f32(F, out_ptr(F), in_ptr(F, 21), out_ptr(F));
        )
}
#undef PH_SITE
#undef WSP

__global__ void __launch_bounds__(NWAVES * 64, 2) trunk_fwd(Args args) {
    extern __shared__ __attribute__((aligned(16))) unsigned char lds[];
    LAS unsigned char* const ldsp = (LAS unsigned char*)lds;
    {
        const int tid = threadIdx.x;
        for (int u = tid; u < (LDS_BYTES - LDSCTL_OFF) / 4; u += NWAVES * 64) ((LAS unsigned*)(ldsp + LDSCTL_OFF))[u] = 0u;
        __syncthreads();
        if (tid == 0) { volatile LAS unsigned long long* tab = (volatile LAS unsigned long long*)(ldsp + LDSCTL_OFF);
#pragma unroll
            for (int i = 0; i < 22; ++i) tab[i] = (unsigned long long)args.in[i];
            tab[22] = (unsigned long long)args.out; tab[23] = (unsigned long long)args.ws; }
        __syncthreads();
    }
    const int lo = args.ph_lo, hi = args.ph_hi;
    XcdBarrier bar; bar.bar = (unsigned*)(args.ws + WS_CTL) + CW_BAR; bar.x = 0; bar.st = nullptr;
    if (hi - lo > 1) bar = xcd_barrier_post((unsigned*)(args.ws + WS_CTL) + CW_BAR, (volatile LAS unsigned*)(ldsp + MISC_OFF) + 8);
    int ph = 0;
#ifndef PROBE_TWICE_MASK
#define PROBE_TWICE_MASK 0
#endif
#define PH_SITE(site, ...) if (ph >= lo && ph < hi) { { const Frame F = make_frame(ldsp, nullptr); __VA_ARGS__ if (ph + 1 < hi || ((PROBE_TWICE_MASK >> (site)) & 1)) { xcd_barrier(bar); if (PROBE_BAR2) xcd_barrier(bar); } } \
        if ((PROBE_TWICE_MASK >> (site)) & 1) { const Frame F = make_frame(ldsp, nullptr); __VA_ARGS__ if (ph + 1 < hi) xcd_barrier(bar); } } ++ph;
#define WSP(off) (ws_ptr(F) + (off))

    PH_SITE(0,
    {
        unsigned char* ws = ws_ptr(F);
        tr_run(F, ws, F.gw, TR_PRO, F.NGW);
        rmsnorm_rows_bf16(F, in_ptr(F, 0), in_ptr(F, 1), (bf16*)(ws + WS_XN));
    }
    )

    layer_phases<0>(ldsp, lo, hi, ph, bar); layer_phases<1>(ldsp, lo, hi, ph, bar); layer_phases<2>(ldsp, lo, hi, ph, bar); layer_phases<3>(ldsp, lo, hi, ph, bar);
#undef PH_SITE
#undef WSP
}

#ifndef MK_ONE_LAUNCH
#define MK_ONE_LAUNCH 1
#endif
extern "C" void kernel_launch(void* const* d_in, const int* in_sizes, int n_in, void* d_out, int out_size, void* d_ws, size_t ws_size, hipStream_t stream) {
    static int grid = 0;
    if (grid == 0) {
        if (n_in != 22 || in_sizes[0] != MTOK * DM || out_size != MTOK * DM || ws_size < WS_END) { fprintf(stderr, "kernel_launch: unexpected shapes (n_in %d, in0 %d, out %d, ws %zu < %zu)\n", n_in, n_in > 0 ? in_sizes[0] : -1, out_size, ws_size, (size_t)WS_END); grid = -1; return; }
        int dev = 0, cus = 0, per_cu = 0;
        if (hipGetDevice(&dev) != hipSuccess || hipDeviceGetAttribute(&cus, hipDeviceAttributeMultiprocessorCount, dev) != hipSuccess) { grid = -1; return; }
        if (hipFuncSetAttribute((const void*)trunk_fwd, hipFuncAttributeMaxDynamicSharedMemorySize, LDS_BYTES) != hipSuccess) { fprintf(stderr, "kernel_launch: hipFuncSetAttribute failed\n"); grid = -1; return; }
        if (hipOccupancyMaxActiveBlocksPerMultiprocessor(&per_cu, (const void*)trunk_fwd, NWAVES * 64, LDS_BYTES) != hipSuccess || per_cu < 1) fprintf(stderr, "kernel_launch: occupancy query reports %d\n", per_cu);
        (void)hipGetLastError();
        grid = cus;
    }
    if (grid < 0) return;
    if (hipMemsetAsync((char*)d_ws + WS_CTL, 0, CTL_ZERO_BYTES, stream) != hipSuccess) return;
    Args a{};
    for (int i = 0; i < 22; ++i) a.in[i] = (const float*)d_in[i];
    a.out = (float*)d_out; a.ws = (unsigned char*)d_ws;
#if MK_ONE_LAUNCH
    a.ph_lo = 0; a.ph_hi = NPHASES;
    hipLaunchKernelGGL(trunk_fwd, dim3(grid), dim3(NWAVES * 64), LDS_BYTES, stream, a);
#else
    for (int p = 0; p < NPHASES; ++p) { a.ph_lo = p; a.ph_hi = p + 1; hipLaunchKernelGGL(trunk_fwd, dim3(grid), dim3(NWAVES * 64), LDS_BYTES, stream, a); }
#endif
}
```

```cpp
#include <hip/hip_runtime.h>
#include <cstdio>
#include <cstdint>
namespace pg8 {
#define PG8_LAS __attribute__((address_space(3)))
typedef unsigned short bf16_t;
typedef short bf16x8 __attribute__((ext_vector_type(8)));
typedef float f32x4 __attribute__((ext_vector_type(4)));
typedef unsigned u32x4 __attribute__((ext_vector_type(4)));
constexpr int BM = 256, BK = 64, HALF = 128, HTB = HALF * BK * 2  , STAGE_BYTES = 8 * HTB, NXCD = 8, WGM = 8;

__host__ __device__ __forceinline__ int lds_byte(int r, int c) { const int st = (r >> 4) * 2 + (c >> 5), rr = r & 15, cc = c & 31, ob = rr * 64 + cc * 2; return st * 1024 + (ob ^ (((ob >> 9) & 1) << 5)); }
__host__ __device__ __forceinline__ void stage_rc(int b, int& R, int& C) { const int st = b / 1024, sb = b % 1024, swz = sb ^ (((sb >> 9) & 1) << 5); R = (st >> 1) * 16 + swz / 64; C = (st & 1) * 32 + (swz % 64) / 2; }
__host__ __device__ __forceinline__ int perm32(int rho) { const int n = rho >> 4, i = rho & 15; return 8 * (i >> 2) + 4 * n + (i & 3); }

struct Unit { int pm, pn; };
struct Gemm { const bf16_t* A; const bf16_t* Bt; int M, N, K, lda, ldb; };

struct StaticOrder {
    int nM, nN, nwg, G, c, wgm;
    __host__ __device__ void init(int M, int N, int G_, int c_, int wgm_ = WGM) { nM = M / BM; nN = N / BM; nwg = nM * nN; G = G_; c = c_; wgm = wgm_; }
    __host__ __device__ bool next(int i, Unit& u) const {
        const long L = (long)i * G + c; if (L >= nwg) return false;
        int wgid = (int)L; { const int q = nwg / NXCD, r = nwg % NXCD, xcd = wgid % NXCD, off = wgid / NXCD; wgid = (xcd < r ? xcd * (q + 1) : r * (q + 1) + (xcd - r) * q) + off; }
        const int nig = wgm * nN, gid = wgid / nig, fm = gid * wgm, gsz = (nM - fm) < wgm ? (nM - fm) : wgm;
        u.pm = fm + ((wgid % nig) % gsz); u.pn = (wgid % nig) / gsz; return true;
    }
    __device__ __forceinline__ void a_ready(const Unit&) const {}
    __device__ __forceinline__ void done(const Unit&) const {}
};

template <class Epi, class Sched, bool ALIGN_EPI = false, bool SP2 = false>
__device__ __forceinline__ void gemm_phase(PG8_LAS unsigned char* lds, const Gemm g, const Sched& S, const Epi& E) {
    int tid_l = (int)threadIdx.x; asm volatile("" : "+v"(tid_l));
    const int tid = tid_l, wid = __builtin_amdgcn_readfirstlane(tid >> 6), lane = tid & 63, wr = wid >> 2, wc = wid & 3, fr = lane & 15, fq = lane >> 4;
    const int K = g.K, nt = K / BK;
    unsigned voffA[2], voffB[2];
#pragma unroll
    for (int i = 0; i < 2; ++i) { int R, C; stage_rc(tid * 16 + i * 8192, R, C); const int Rb = Epi::PERM ? ((R & ~31) + perm32(R & 31)) : R;
        voffA[i] = (unsigned)(R * g.lda + C) * 2u; voffB[i] = (unsigned)(Rb * g.ldb + C) * 2u; }
    const size_t kstep = (size_t)(BK * 2);
    const size_t hstepA = (size_t)HALF * g.lda * 2, hstepB = (size_t)HALF * g.ldb * 2;
    const size_t tstepA = 2 * hstepA, tstepB = 2 * hstepB;
    const unsigned ldsw = (unsigned)wid * 1024u;
    const int aoff = lds_byte(wr * 64 + fr, fq * 8), boff = lds_byte(wc * 32 + fr, fq * 8);
#define PG8_SA(b, h) (((b) * 2 + (h)) * HTB)
#define PG8_SB(b, h) ((4 + (b) * 2 + (h)) * HTB)
#define PG8_STAGE(bufoff, gbase, voff) do { _Pragma("unroll") for (int _i = 0; _i < 2; ++_i) \
        __builtin_amdgcn_global_load_lds((const unsigned*)((const char*)(gbase) + (voff)[_i]), (PG8_LAS unsigned*)(lds + (bufoff) + ldsw + _i * 8192), 16, 0, 0); } while (0)
#define PG8_LDA(dst, b, h) do { _Pragma("unroll") for (int m = 0; m < 4; ++m) _Pragma("unroll") for (int k = 0; k < 2; ++k) dst[m][k] = *(const PG8_LAS bf16x8*)(lds + PG8_SA(b, h) + aoff + m * 2048 + k * 1024); } while (0)
#define PG8_LDB(dst, b, h) do { _Pragma("unroll") for (int n = 0; n < 2; ++n) _Pragma("unroll") for (int k = 0; k < 2; ++k) dst[n][k] = *(const PG8_LAS bf16x8*)(lds + PG8_SB(b, h) + boff + n * 2048 + k * 1024); } while (0)
#define PG8_MMA(ai, bj, At, Bt) do { __builtin_amdgcn_s_setprio(1); _Pragma("unroll") for (int m = 0; m < 4; ++m) _Pragma("unroll") for (int n = 0; n < 2; ++n) _Pragma("unroll") for (int k = 0; k < 2; ++k) \
        acc[ai][bj][m][n] = __builtin_amdgcn_mfma_f32_16x16x32_bf16(Bt[n][k], At[m][k], acc[ai][bj][m][n], 0, 0, 0); __builtin_amdgcn_s_setprio(0); } while (0)
#define PG8_WAIT_V(n) asm volatile("s_waitcnt vmcnt(" #n ")" ::: "memory")
#define PG8_WAIT_L(n) asm volatile("s_waitcnt lgkmcnt(" #n ")" ::: "memory")
#define PG8_BAR __builtin_amdgcn_s_barrier()
#define PG8_SCHED __builtin_amdgcn_sched_barrier(0)
    Unit cur, nxt; int ui = 0;
    if (!S.next(0, cur)) return;
    f32x4 acc[2][2][4][2];
#pragma unroll
    for (int a = 0; a < 2; ++a)
#pragma unroll
        for (int b = 0; b < 2; ++b)
#pragma unroll
            for (int m = 0; m < 4; ++m)
#pragma unroll
                for (int n = 0; n < 2; ++n) acc[a][b][m][n] = (f32x4){0.f, 0.f, 0.f, 0.f};
    bf16x8 At[4][2], B0[2][2], B1[2][2];
    const char* cA = (const char*)g.A + (size_t)cur.pm * tstepA; const char* cB = (const char*)g.Bt + (size_t)cur.pn * tstepB;
    S.a_ready(cur);
    if constexpr (SP2) {
        PG8_STAGE(PG8_SB(0, 0), cB, voffB); PG8_STAGE(PG8_SB(0, 1), cB + hstepB, voffB); PG8_STAGE(PG8_SA(0, 0), cA, voffA); PG8_STAGE(PG8_SA(0, 1), cA + hstepA, voffA);
        if (wr == 1) PG8_BAR;
        PG8_WAIT_V(2); PG8_BAR;
        PG8_STAGE(PG8_SB(1, 0), cB + kstep, voffB); PG8_STAGE(PG8_SA(1, 0), cA + kstep, voffA); PG8_STAGE(PG8_SB(1, 1), cB + hstepB + kstep, voffB);
        PG8_WAIT_V(6); PG8_BAR;
    } else {
        PG8_STAGE(PG8_SB(0, 0), cB, voffB); PG8_STAGE(PG8_SA(0, 0), cA, voffA); PG8_STAGE(PG8_SB(0, 1), cB + hstepB, voffB); PG8_STAGE(PG8_SA(0, 1), cA + hstepA, voffA);
        if (wr == 1) PG8_BAR;
        PG8_WAIT_V(4); PG8_BAR;
        PG8_STAGE(PG8_SB(1, 0), cB + kstep, voffB); PG8_STAGE(PG8_SA(1, 0), cA + kstep, voffA); PG8_STAGE(PG8_SB(1, 1), cB + hstepB + kstep, voffB);
        PG8_WAIT_V(6); PG8_BAR;
    }
    for (;;) {
        const bool has_next = S.next(ui + 1, nxt);
        const char* nA = has_next ? (const char*)g.A + (size_t)nxt.pm * tstepA : cA; const char* nB = has_next ? (const char*)g.Bt + (size_t)nxt.pn * tstepB : cB;
        for (int t = 0; t < nt; t += 2) {
            if constexpr (Epi::MIDK) { if (t == E.t1 || t == E.t2) E.mid(acc, cur, t, wr, wc, fr, fq); }
            const bool last = (t == nt - 2);
            const char* a1 = cA + (size_t)(t + 1) * kstep;
            const char* a2 = last ? nA : cA + (size_t)(t + 2) * kstep; const char* b2 = last ? nB : cB + (size_t)(t + 2) * kstep;
            const char* a3 = a2 + kstep; const char* b3 = b2 + kstep;
            if (last && has_next) S.a_ready(nxt);
            if constexpr (SP2) {
            PG8_LDB(B0, 0, 0); PG8_LDB(B1, 0, 1); PG8_SCHED; PG8_LDA(At, 0, 0); PG8_STAGE(PG8_SA(1, 1), a1 + hstepA, voffA);
            PG8_WAIT_V(8); PG8_WAIT_L(0); PG8_BAR; PG8_MMA(0, 0, At, B0); PG8_MMA(0, 1, At, B1); PG8_BAR; PG8_SCHED;
            PG8_LDA(At, 0, 1); PG8_STAGE(PG8_SB(0, 0), b2, voffB); PG8_STAGE(PG8_SB(0, 1), b2 + hstepB, voffB); PG8_STAGE(PG8_SA(0, 0), a2, voffA);
            PG8_WAIT_V(8); PG8_WAIT_L(0); PG8_BAR; PG8_MMA(1, 0, At, B0); PG8_MMA(1, 1, At, B1); PG8_BAR; PG8_SCHED;
            PG8_LDB(B0, 1, 0); PG8_LDB(B1, 1, 1); PG8_SCHED; PG8_LDA(At, 1, 0); PG8_STAGE(PG8_SA(0, 1), a2 + hstepA, voffA);
            PG8_WAIT_V(8); PG8_WAIT_L(0); PG8_BAR; PG8_MMA(0, 0, At, B0); PG8_MMA(0, 1, At, B1); PG8_BAR; PG8_SCHED;
            PG8_LDA(At, 1, 1); PG8_STAGE(PG8_SB(1, 0), b3, voffB); PG8_STAGE(PG8_SB(1, 1), b3 + hstepB, voffB); PG8_STAGE(PG8_SA(1, 0), a3, voffA);
            PG8_WAIT_V(8); PG8_WAIT_L(0); PG8_BAR; PG8_MMA(1, 0, At, B0); PG8_MMA(1, 1, At, B1); PG8_BAR; PG8_SCHED;
            } else {
            PG8_LDB(B0, 0, 0); PG8_SCHED; PG8_LDA(At, 0, 0); PG8_STAGE(PG8_SA(1, 1), a1 + hstepA, voffA);
            PG8_WAIT_L(8); PG8_BAR; PG8_WAIT_L(0); PG8_MMA(0, 0, At, B0); PG8_BAR; PG8_SCHED;
            PG8_LDB(B1, 0, 1); PG8_STAGE(PG8_SB(0, 0), b2, voffB);
            PG8_BAR; PG8_WAIT_L(0); PG8_MMA(0, 1, At, B1); PG8_BAR;
            PG8_LDA(At, 0, 1); PG8_STAGE(PG8_SA(0, 0), a2, voffA);
            PG8_BAR; PG8_WAIT_L(0); PG8_MMA(1, 0, At, B0); PG8_BAR; PG8_SCHED;
            PG8_STAGE(PG8_SB(0, 1), b2 + hstepB, voffB);
            PG8_WAIT_V(6); PG8_BAR; PG8_MMA(1, 1, At, B1); PG8_BAR;
            PG8_LDB(B0, 1, 0); PG8_SCHED; PG8_LDA(At, 1, 0); PG8_STAGE(PG8_SA(0, 1), a2 + hstepA, voffA);
            PG8_WAIT_L(8); PG8_BAR; PG8_WAIT_L(0); PG8_MMA(0, 0, At, B0); PG8_BAR; PG8_SCHED;
            PG8_LDB(B1, 1, 1); PG8_STAGE(PG8_SB(1, 0), b3, voffB);
            PG8_BAR; PG8_WAIT_L(0); PG8_MMA(0, 1, At, B1); PG8_BAR;
            PG8_LDA(At, 1, 1); PG8_STAGE(PG8_SA(1, 0), a3, voffA);
            PG8_BAR; PG8_WAIT_L(0); PG8_MMA(1, 0, At, B0); PG8_BAR; PG8_SCHED;
            PG8_STAGE(PG8_SB(1, 1), b3 + hstepB, voffB);
            PG8_WAIT_V(6); PG8_BAR; PG8_MMA(1, 1, At, B1); PG8_BAR;
            }
        }
        if constexpr (ALIGN_EPI) { if (wr == 0) PG8_BAR; }
        if constexpr (!Epi::AFTER_DRAIN) { E(acc, cur, wr, wc, fr, fq); S.done(cur); }
        if (!has_next) break;
#pragma unroll
        for (int a = 0; a < 2; ++a)
#pragma unroll
            for (int b = 0; b < 2; ++b)
#pragma unroll
                for (int m = 0; m < 4; ++m)
#pragma unroll
                    for (int n = 0; n < 2; ++n) acc[a][b][m][n] = (f32x4){0.f, 0.f, 0.f, 0.f};
        cur = nxt; cA = nA; cB = nB; ++ui;
        if constexpr (ALIGN_EPI) { if (wr == 1) PG8_BAR; }
    }
    PG8_WAIT_V(0);
    if constexpr (!ALIGN_EPI) { if (wr == 0) PG8_BAR; }
    PG8_BAR;
    if constexpr (Epi::AFTER_DRAIN) { E.fused(acc, cur, wr, wc, fr, fq, lds, wid, lane); S.done(cur); }
#undef PG8_SA
#undef PG8_SB
#undef PG8_STAGE
#undef PG8_LDA
#undef PG8_LDB
#undef PG8_MMA
#undef PG8_WAIT_V
#undef PG8_WAIT_L
#undef PG8_BAR
#undef PG8_SCHED
}
}
#define GAS __attribute__((address_space(1)))
#define LAS __attribute__((address_space(3)))
typedef unsigned short bf16;
typedef unsigned v4u __attribute__((ext_vector_type(4)));
typedef float f32x4 __attribute__((ext_vector_type(4)));
typedef short bf16x8 __attribute__((ext_vector_type(8)));
typedef GAS unsigned gu32;
typedef GAS unsigned long long gu64;
#define RLX_AGENT __ATOMIC_RELAXED, __HIP_MEMORY_SCOPE_AGENT
#define LDS_WAIT() asm volatile("s_waitcnt lgkmcnt(0)" ::: "memory")
#define VM_WAIT() asm volatile("s_waitcnt vmcnt(0)" ::: "memory")
__device__ __forceinline__ unsigned long long rt() { return __builtin_amdgcn_s_memrealtime(); }
__device__ __forceinline__ unsigned f2bf(float f) { unsigned u = __builtin_bit_cast(unsigned, f); return (u + 0x7fffu + ((u >> 16) & 1u)) >> 16; }
__device__ __forceinline__ unsigned pk2(float lo, float hi) { return f2bf(lo) | (f2bf(hi) << 16); }

#define XB_TMO      128
#define XB_XCNT(j)  (256  + 64 * (j))
#define XB_XSUB(j)  (1280 + 64 * (j))
#define XB_XGEN(j)  (2304 + 64 * (j))
#define XB_TOP      3328
#define XB_TOPGEN   3392
#define XCD_BAR_WORDS 3456
#define XB_SPIN_CAP (1u << 18)

__device__ __forceinline__ unsigned xb_ld(unsigned* p)              { return __hip_atomic_load(p, __ATOMIC_RELAXED, __HIP_MEMORY_SCOPE_AGENT); }
__device__ __forceinline__ unsigned xb_add(unsigned* p, unsigned v) { return __hip_atomic_fetch_add(p, v, __ATOMIC_RELAXED, __HIP_MEMORY_SCOPE_AGENT); }
__device__ __forceinline__ unsigned xb_xcc_id() { return (unsigned)__builtin_amdgcn_s_getreg((3 << 11) | 20) & 0xFu; }
#define XB_SPIN(cond, bar) do { unsigned _sp = 0; while (cond) { __builtin_amdgcn_s_sleep(1); \
    if ((++_sp & 255u) == 0u) { if (xb_ld(&(bar)[XB_TMO])) break; if (_sp > XB_SPIN_CAP) { atomicAdd(&(bar)[XB_TMO], 1u); break; } } } } while (0)

struct XcdBarrier {
    unsigned* bar; unsigned x;
    volatile LAS unsigned* st;
};

__device__ __forceinline__ XcdBarrier xcd_barrier_post(unsigned* bar, volatile LAS unsigned* st) {
    XcdBarrier b; b.bar = bar; b.x = xb_xcc_id(); b.st = st;
    if (threadIdx.x == 0) (void)xb_add(&bar[XB_XCNT(b.x)], 1u);
    return b;
}
__device__ __forceinline__ void xcd_barrier_complete(unsigned* bar, unsigned x, unsigned& nloc, unsigned& nx) {
    const unsigned G = gridDim.x * gridDim.y * gridDim.z;
    unsigned sum, cnt, mine, sp = 0u;
    for (;;) {
        sum = 0u; cnt = 0u; mine = 0u;
#pragma unroll
        for (unsigned j = 0; j < 16; ++j) { const unsigned c = xb_ld(&bar[XB_XCNT(j)]); sum += c; cnt += (c > 0u) ? 1u : 0u; mine = (j == x) ? c : mine; }
        if (sum == G) break;
        __builtin_amdgcn_s_sleep(1);
        if ((++sp & 255u) == 0u) { if (xb_ld(&bar[XB_TMO])) break; if (sp > XB_SPIN_CAP) { atomicAdd(&bar[XB_TMO], 1u); break; } }
    }
    nloc = mine > 0u ? mine : 1u; nx = cnt > 0u ? cnt : 1u;
}

__device__ __forceinline__ void xcd_barrier(const XcdBarrier& b) {
    asm volatile("s_waitcnt vmcnt(0)" ::: "memory");
    __syncthreads();
    if (threadIdx.x == 0) {
        unsigned* bar = b.bar;
        __builtin_amdgcn_s_waitcnt(0);
        unsigned nloc = b.st[0], nx = b.st[1];
        if (nloc == 0u) { xcd_barrier_complete(bar, b.x, nloc, nx); b.st[0] = nloc; b.st[1] = nx; }
        const unsigned old = xb_add(&bar[XB_XSUB(b.x)], 1u);
        const unsigned gen = old / nloc;
        if (old + 1u == (gen + 1u) * nloc) {
            __builtin_amdgcn_fence(__ATOMIC_RELEASE, "agent");
            asm volatile("s_waitcnt vmcnt(0)" ::: "memory");
            const unsigned og = xb_add(&bar[XB_TOP], 1u);
            const unsigned tg = og / nx;
            if (og + 1u == (tg + 1u) * nx) xb_add(&bar[XB_TOPGEN], 1u);
            else XB_SPIN(xb_ld(&bar[XB_TOPGEN]) == tg, bar);
            __builtin_amdgcn_fence(__ATOMIC_ACQUIRE, "agent");
            xb_add(&bar[XB_XGEN(b.x)], 1u);
            asm volatile("s_waitcnt vmcnt(0)" ::: "memory");
        } else {
            XB_SPIN(xb_ld(&bar[XB_XGEN(b.x)]) == gen, bar);
            __builtin_amdgcn_fence(__ATOMIC_ACQUIRE, "agent");
            asm volatile("s_waitcnt vmcnt(0)" ::: "memory");
        }
    }
    __syncthreads();
}

namespace pg8 {
__device__ __forceinline__ unsigned cvt_pk_bf16(float lo, float hi) { unsigned r; asm volatile("v_cvt_pk_bf16_f32 %0, %1, %2" : "=v"(r) : "v"(lo), "v"(hi)); return r; }
__device__ __forceinline__ float bflo(unsigned w) { return __uint_as_float(w << 16); }
__device__ __forceinline__ float bfhi(unsigned w) { return __uint_as_float(w & 0xffff0000u); }
__device__ __forceinline__ float fast_sigmoid(float x) { return __builtin_amdgcn_rcpf(1.0f + __builtin_amdgcn_exp2f(-1.4426950408889634f * x)); }

struct EpiSwiglu {
    static constexpr bool PERM = true, AFTER_DRAIN = false, MIDK = false;
    bf16_t* H; int ldh;
    __device__ __forceinline__ void operator()(const f32x4 (&acc)[2][2][4][2], const Unit& u, int wr, int wc, int fr, int fq) const {
        const int row0 = u.pm * BM + wr * 64 + fr, col0 = u.pn * HALF + wc * 32 + 8 * fq;
#pragma unroll
        for (int ai = 0; ai < 2; ++ai)
#pragma unroll
            for (int m = 0; m < 4; ++m) { bf16_t* rowp = H + (size_t)(row0 + ai * HALF + m * 16) * ldh + col0;
                float h[8];
#pragma unroll
                for (int n = 0; n < 2; ++n)
#pragma unroll
                    for (int j = 0; j < 4; ++j) { const float a = acc[ai][0][m][n][j], b = acc[ai][1][m][n][j]; h[n * 4 + j] = a * fast_sigmoid(a) * b; }
                u32x4 w; w.x = cvt_pk_bf16(h[0], h[1]); w.y = cvt_pk_bf16(h[2], h[3]); w.z = cvt_pk_bf16(h[4], h[5]); w.w = cvt_pk_bf16(h[6], h[7]);
                *(u32x4*)rowp = w; }
    }
};
struct EpiRes {
    static constexpr bool PERM = false, AFTER_DRAIN = false, MIDK = false;
    const float* base; float* out; int ld; float s;
    __device__ __forceinline__ void operator()(const f32x4 (&acc)[2][2][4][2], const Unit& u, int wr, int wc, int fr, int fq) const {
        const int row0 = u.pm * BM + wr * 64 + fr, col0 = u.pn * BM + wc * 32 + 4 * fq;
#pragma unroll
        for (int ai = 0; ai < 2; ++ai)
#pragma unroll
            for (int m = 0; m < 4; ++m) { const size_t off = (size_t)(row0 + ai * HALF + m * 16) * ld + col0;
#pragma unroll
                for (int bj = 0; bj < 2; ++bj)
#pragma unroll
                    for (int n = 0; n < 2; ++n) { const f32x4 b = *(const f32x4*)(base + off + bj * HALF + n * 16); *(f32x4*)(out + off + bj * HALF + n * 16) = b + acc[ai][bj][m][n] * s; } }
    }
};
struct EpiCols {
    static constexpr bool PERM = true, AFTER_DRAIN = false, MIDK = false;
    bf16_t* O; int ldc; int sig_from;
    __device__ __forceinline__ void operator()(const f32x4 (&acc)[2][2][4][2], const Unit& u, int wr, int wc, int fr, int fq) const {
        const int row0 = u.pm * BM + wr * 64 + fr, col0 = u.pn * BM + wc * 32 + 8 * fq; const bool sg = u.pn >= sig_from;
#pragma unroll
        for (int ai = 0; ai < 2; ++ai)
#pragma unroll
            for (int m = 0; m < 4; ++m) { bf16_t* rowp = O + (size_t)(row0 + ai * HALF + m * 16) * ldc + col0;
#pragma unroll
                for (int bj = 0; bj < 2; ++bj) { f32x4 v0 = acc[ai][bj][m][0], v1 = acc[ai][bj][m][1];
                    if (sg) {
#pragma unroll
                        for (int j = 0; j < 4; ++j) { v0[j] = fmaxf(fast_sigmoid(v0[j]), 1e-6f); v1[j] = fmaxf(fast_sigmoid(v1[j]), 1e-6f); } }
                    u32x4 w; w.x = cvt_pk_bf16(v0[0], v0[1]); w.y = cvt_pk_bf16(v0[2], v0[3]); w.z = cvt_pk_bf16(v1[0], v1[1]); w.w = cvt_pk_bf16(v1[2], v1[3]);
                    *(u32x4*)(rowp + bj * HALF) = w; } }
    }
};
struct EpiProjF {
    static constexpr bool PERM = true, AFTER_DRAIN = false, MIDK = true;
    const bf16_t* G; int ldg; bf16_t* Z; int ld; int t1, t2;
    __device__ __forceinline__ void mid(f32x4 (&acc)[2][2][4][2], const Unit& u, int t, int wr, int wc, int fr, int fq) const {
        int fr_l = fr; asm volatile("" : "+v"(fr_l));
        const int seg = t == t1 ? 0 : 1; const int row0 = u.pm * BM + wr * 64 + fr_l, col0 = u.pn * BM + wc * 32 + 8 * fq;
#pragma unroll
        for (int ai = 0; ai < 2; ++ai)
#pragma unroll
          for (int mh = 0; mh < 2; ++mh) { u32x4 ga[2][2], gb[2][2];
#pragma unroll
            for (int mm = 0; mm < 2; ++mm)
#pragma unroll
                for (int bj = 0; bj < 2; ++bj) { const bf16_t* gp = G + (size_t)(row0 + ai * HALF + (mh * 2 + mm) * 16) * ldg + seg * 2048 + col0 + bj * HALF; ga[mm][bj] = *(const u32x4*)gp; gb[mm][bj] = *(const u32x4*)(gp + 2048); }
            asm volatile("s_waitcnt vmcnt(0)" ::: "memory");
#pragma unroll
            for (int mm = 0; mm < 2; ++mm)
#pragma unroll
                for (int bj = 0; bj < 2; ++bj) { const u32x4 a = ga[mm][bj], b = gb[mm][bj]; const int m = mh * 2 + mm;
                    const f32x4 r0 = {bflo(a.x) * __builtin_amdgcn_rcpf(bflo(b.x)), bfhi(a.x) * __builtin_amdgcn_rcpf(bfhi(b.x)), bflo(a.y) * __builtin_amdgcn_rcpf(bflo(b.y)), bfhi(a.y) * __builtin_amdgcn_rcpf(bfhi(b.y))};
                    const f32x4 r1 = {bflo(a.z) * __builtin_amdgcn_rcpf(bflo(b.z)), bfhi(a.z) * __builtin_amdgcn_rcpf(bfhi(b.z)), bflo(a.w) * __builtin_amdgcn_rcpf(bflo(b.w)), bfhi(a.w) * __builtin_amdgcn_rcpf(bfhi(b.w))};
                    acc[ai][bj][m][0] *= r0; acc[ai][bj][m][1] *= r1; }
            asm volatile("" ::: "memory"); }
    }
    __device__ __forceinline__ void operator()(const f32x4 (&acc)[2][2][4][2], const Unit& u, int wr, int wc, int fr, int fq) const {
        const int row0 = u.pm * BM + wr * 64 + fr, col0 = u.pn * BM + wc * 32 + 8 * fq;
#pragma unroll
        for (int ai = 0; ai < 2; ++ai)
#pragma unroll
            for (int m = 0; m < 4; ++m) { const int row = row0 + ai * HALF + m * 16;
#pragma unroll
                for (int bj = 0; bj < 2; ++bj) { const int col = col0 + bj * HALF; const u32x4 gw = *(const u32x4*)(G + (size_t)row * ldg + 4096 + col);
                    const f32x4 g0 = {bflo(gw.x), bfhi(gw.x), bflo(gw.y), bfhi(gw.y)}, g1 = {bflo(gw.z), bfhi(gw.z), bflo(gw.w), bfhi(gw.w)};
                    const f32x4 v0 = acc[ai][bj][m][0] * g0, v1 = acc[ai][bj][m][1] * g1;
                    u32x4 w; w.x = cvt_pk_bf16(v0[0], v0[1]); w.y = cvt_pk_bf16(v0[2], v0[3]); w.z = cvt_pk_bf16(v1[0], v1[1]); w.w = cvt_pk_bf16(v1[2], v1[3]);
                    *(u32x4*)(Z + (size_t)row * ld + col) = w; } }
    }
};
}

#ifndef MK_FILLER
#define MK_FILLER 1
#endif
#ifndef WGM_WIDE
#define WGM_WIDE 8
#endif
#ifndef WGM_NARROW
#define WGM_NARROW 8
#endif
#ifndef PROBE_BAR2
#define PROBE_BAR2 0
#endif
#ifndef PROBE_SUB
#define PROBE_SUB 0
#endif
constexpr int NWAVES = 8;
constexpr int DM = 2048, NB = 4, SEQ = 2048, DEPTH = 4, MTOK = NB * SEQ, DFF = 5632;
constexpr int NCOLS = 11520;
constexpr int C_QA = 0, C_KA = 768, C_VA = 1536, C_XB = 2304, C_QC = 2816, C_KCMP = 3584, C_VCMP = 3840, C_KSLC = 4096, C_VSLC = 4352, C_KWIN = 4608, C_VWIN = 4864,
              C_GM = 5120  , C_GC = 11264  ;
constexpr int SIG_TILE = C_GM / 256;
constexpr int NBR = 1536;
constexpr float EPS = 1e-6f;
constexpr int NPH_LAYER = 13, NPHASES = 1 + DEPTH * NPH_LAYER;

constexpr size_t MiB = 1u << 20;
constexpr size_t WS_CTL = 0, CTL_ZERO_BYTES = 1 * MiB;
constexpr size_t WS_W = 2 * MiB, W_LAYER = 194 * MiB;
constexpr size_t WO_WI1 = 0, WO_WO1 = 44 * MiB, WO_WIN = 66 * MiB, WO_PROJ = 111 * MiB, WO_WOUT = 117 * MiB, WO_WI2 = 125 * MiB, WO_WO2 = 169 * MiB,
                 WO_C1K = 191 * MiB, WO_C1V = 192 * MiB, WO_C2K = 193 * MiB, WO_C2V = 193 * MiB + 32768, WO_POOL = 193 * MiB + 65536, WO_PEB = 193 * MiB + 262144;
constexpr size_t WS_XN = 780 * MiB, WS_H = 812 * MiB, WS_COLS = 900 * MiB, WS_BR = 1080 * MiB, WS_ZF = 1104 * MiB, WS_Z = 1168 * MiB, WS_OG = 1200 * MiB, WS_LSE = 1224 * MiB,
                 WS_OC = 1225 * MiB, WS_OW = 1249 * MiB, WS_SEL = 1273 * MiB, WS_KC = 1274 * MiB, WS_VC = 1274 * MiB + 512 * 1024, WS_END = 1276 * MiB;
static_assert(WS_W + DEPTH * W_LAYER <= WS_XN, "weights");
static_assert(WS_H + (size_t)MTOK * DFF * 2 <= WS_COLS && WS_COLS + (size_t)MTOK * NCOLS * 2 <= WS_BR && WS_BR + (size_t)MTOK * NBR * 2 <= WS_ZF, "ws map");
constexpr int CW_BAR = 4096;

constexpr int RING_OFF = 0, RING_BYTES = 131072;
constexpr int LDSCTL_OFF = RING_BYTES, MISC_OFF = LDSCTL_OFF + 320;
constexpr int LDS_BYTES = 147456;

__device__ __forceinline__ float bf2f(bf16 h) { return __uint_as_float((unsigned)h << 16); }
__device__ __forceinline__ float wave_sum(float v) {
#pragma unroll
    for (int o = 1; o < 64; o <<= 1) v += __shfl_xor(v, o);
    return v;
}
__device__ __forceinline__ float wave_max(float v) {
#pragma unroll
    for (int o = 1; o < 64; o <<= 1) v = fmaxf(v, __shfl_xor(v, o));
    return v;
}
__device__ __forceinline__ void load8(const bf16* p, float (&f)[8]) {
    const v4u w = *(const v4u*)p;
    f[0] = pg8::bflo(w.x); f[1] = pg8::bfhi(w.x); f[2] = pg8::bflo(w.y); f[3] = pg8::bfhi(w.y); f[4] = pg8::bflo(w.z); f[5] = pg8::bfhi(w.z); f[6] = pg8::bflo(w.w); f[7] = pg8::bfhi(w.w);
}

struct Frame {
    LAS unsigned char* lds;
    volatile LAS unsigned* MISC;
    gu32* ctl;
    volatile LAS unsigned long long* tab;
    int tid, lane, wave, vcu, G, bx, gw, NGW;
};
__device__ __forceinline__ Frame make_frame(LAS unsigned char* lds, unsigned char* ws_ctl) {
    Frame F; int tid = (int)threadIdx.x, G = (int)gridDim.x, bx = (int)blockIdx.x;
    asm volatile("" : "+v"(tid)); asm volatile("" : "+s"(G), "+s"(bx));
    F.lds = lds; F.MISC = (volatile LAS unsigned*)(lds + MISC_OFF); F.tab = (volatile LAS unsigned long long*)(lds + LDSCTL_OFF);
    F.tid = tid; F.lane = tid & 63; F.wave = __builtin_amdgcn_readfirstlane(tid >> 6);
    F.G = G; F.bx = bx; F.vcu = (G % 8 == 0) ? (bx % 8) * (G / 8) + bx / 8 : bx;
    F.gw = F.vcu * NWAVES + F.wave; F.NGW = G * NWAVES; F.ctl = (gu32*)ws_ctl;
    return F;
}
__device__ __forceinline__ unsigned long long tab_get(const Frame& F, int i) {
    const unsigned long long v = F.tab[i];
    const unsigned lo = __builtin_amdgcn_readfirstlane((unsigned)v), hi = __builtin_amdgcn_readfirstlane((unsigned)(v >> 32));
    return ((unsigned long long)hi << 32) | lo;
}
__device__ __forceinline__ const float* in_ptr(const Frame& F, int i) { return (const float*)tab_get(F, i); }
__device__ __forceinline__ float* out_ptr(const Frame& F) { return (float*)tab_get(F, 22); }
__device__ __forceinline__ unsigned char* ws_ptr(const Frame& F) { return (unsigned char*)tab_get(F, 23); }

struct TrDesc { const float* W; bf16* WT; size_t r0; int ldn, c0, nv, k0, ldk, kofs; };
__device__ __forceinline__ void tr_item(const float* W, int ldn, int c0, int nv, int k0, bf16* WT, size_t r0, int ldk, int kofs, LAS float* scr, int lane) {
    float tv[32];
#pragma unroll
    for (int i = 0; i < 32; ++i) { const int kk = 2 * i + (lane >> 5), n = lane & 31; tv[i] = (n < nv) ? __builtin_nontemporal_load(W + (size_t)(k0 + kk) * ldn + c0 + n) : 0.f; }
#pragma unroll
    for (int i = 0; i < 32; ++i) { const int kk = 2 * i + (lane >> 5), n = lane & 31; scr[kk * 33 + n] = tv[i]; }
    LDS_WAIT(); asm volatile("" ::: "memory");
    const int c = lane & 7;
#pragma unroll
    for (int j = 0; j < 4; ++j) { const int n = (lane >> 3) + 8 * j; const LAS float* s = scr + (8 * c) * 33 + n;
        v4u o; o.x = pk2(s[0 * 33], s[1 * 33]); o.y = pk2(s[2 * 33], s[3 * 33]); o.z = pk2(s[4 * 33], s[5 * 33]); o.w = pk2(s[6 * 33], s[7 * 33]);
        *(GAS v4u*)(WT + (r0 + n) * (size_t)ldk + kofs + k0 + 8 * c) = o; }
    LDS_WAIT(); asm volatile("" ::: "memory");
}

__device__ __forceinline__ void tr_item2(const TrDesc& d0, const TrDesc& d1, LAS float* scr, int lane) {
    float tv[64];
#pragma unroll
    for (int i = 0; i < 32; ++i) { const int kk = 2 * i + (lane >> 5), n = lane & 31; tv[i] = (n < d0.nv) ? __builtin_nontemporal_load(d0.W + (size_t)(d0.k0 + kk) * d0.ldn + d0.c0 + n) : 0.f; }
#pragma unroll
    for (int i = 0; i < 32; ++i) { const int kk = 2 * i + (lane >> 5), n = lane & 31; tv[32 + i] = (n < d1.nv) ? __builtin_nontemporal_load(d1.W + (size_t)(d1.k0 + kk) * d1.ldn + d1.c0 + n) : 0.f; }
    const int c = lane & 7;
#pragma unroll
    for (int h = 0; h < 2; ++h) { const TrDesc& d = h ? d1 : d0;
#pragma unroll
        for (int i = 0; i < 32; ++i) { const int kk = 2 * i + (lane >> 5), n = lane & 31; scr[kk * 33 + n] = tv[h * 32 + i]; }
        LDS_WAIT(); asm volatile("" ::: "memory");
#pragma unroll
        for (int j = 0; j < 4; ++j) { const int n = (lane >> 3) + 8 * j; const LAS float* s = scr + (8 * c) * 33 + n;
            v4u o; o.x = pk2(s[0 * 33], s[1 * 33]); o.y = pk2(s[2 * 33], s[3 * 33]); o.z = pk2(s[4 * 33], s[5 * 33]); o.w = pk2(s[6 * 33], s[7 * 33]);
            *(GAS v4u*)(d.WT + (d.r0 + n) * (size_t)d.ldk + d.kofs + d.k0 + 8 * c) = o; }
        LDS_WAIT(); asm volatile("" ::: "memory"); }
}

constexpr int I_WI = 352 * 32, I_WO = 64 * 88, I_WIN = 360 * 32, I_PA = 64 * 4, I_PB = 64 * 8, I_PC = 64 * 12, I_WOUT = 64 * 32, I_C1 = 4 * 64, I_C2 = 4 * 2, I_POOL = 4 * 8;
constexpr int I_LAYER = 2 * I_WI + 2 * I_WO + I_WIN + I_PA + I_PB + I_PC + I_WOUT + 2 * I_C1 + 2 * I_C2 + I_POOL;

__device__ __forceinline__ TrDesc tr_decode(const Frame& F, unsigned char* ws, int l, int r) {
    unsigned char* wl = ws + WS_W + (size_t)l * W_LAYER;
    const float* W; int ldn, mode = 0, nrb, ldk, kofs = 0; bf16* WT;
    if (r < I_WI) { W = in_ptr(F, 2) + (size_t)l * DM * 2 * DFF; ldn = 2 * DFF; mode = 1; nrb = 352; WT = (bf16*)(wl + WO_WI1); ldk = DM; }
    else if ((r -= I_WI) < I_WO) { W = in_ptr(F, 3) + (size_t)l * DFF * DM; ldn = DM; nrb = 64; WT = (bf16*)(wl + WO_WO1); ldk = DFF; }
    else if ((r -= I_WO) < I_WIN) { W = in_ptr(F, 5) + (size_t)l * DM * 11282; ldn = 11282; mode = 2; nrb = 360; WT = (bf16*)(wl + WO_WIN); ldk = DM; }
    else if ((r -= I_WIN) < I_C1) { W = in_ptr(F, 9) + (size_t)l * 4096 * 128; ldn = 128; nrb = 4; WT = (bf16*)(wl + WO_C1K); ldk = 4096; }
    else if ((r -= I_C1) < I_C1) { W = in_ptr(F, 12) + (size_t)l * 4096 * 128; ldn = 128; nrb = 4; WT = (bf16*)(wl + WO_C1V); ldk = 4096; }
    else if ((r -= I_C1) < I_C2) { W = in_ptr(F, 10) + (size_t)l * 16384; ldn = 128; nrb = 4; WT = (bf16*)(wl + WO_C2K); ldk = 128; }
    else if ((r -= I_C2) < I_C2) { W = in_ptr(F, 13) + (size_t)l * 16384; ldn = 128; nrb = 4; WT = (bf16*)(wl + WO_C2V); ldk = 128; }
    else if ((r -= I_C2) < I_POOL) { const int gi = r >> 3; r &= 7; W = in_ptr(F, 6) + (size_t)(l * 4 + gi) * 16384; ldn = 128; nrb = 4; WT = (bf16*)(wl + WO_POOL) + gi * 16384; ldk = 128; }
    else if ((r -= I_POOL) < I_PA) { W = in_ptr(F, 14) + (size_t)l * 256 * DM; ldn = DM; nrb = 64; WT = (bf16*)(wl + WO_PROJ); ldk = NBR; kofs = 0; }
    else if ((r -= I_PA) < I_PB) { W = in_ptr(F, 15) + (size_t)l * 512 * DM; ldn = DM; nrb = 64; WT = (bf16*)(wl + WO_PROJ); ldk = NBR; kofs = 256; }
    else if ((r -= I_PB) < I_PC) { W = in_ptr(F, 16) + (size_t)l * 768 * DM; ldn = DM; nrb = 64; WT = (bf16*)(wl + WO_PROJ); ldk = NBR; kofs = 768; }
    else if ((r -= I_PC) < I_WOUT) { W = in_ptr(F, 17) + (size_t)l * DM * DM; ldn = DM; nrb = 64; WT = (bf16*)(wl + WO_WOUT); ldk = DM; }
    else if ((r -= I_WOUT) < I_WI) { W = in_ptr(F, 19) + (size_t)l * DM * 2 * DFF; ldn = 2 * DFF; mode = 1; nrb = 352; WT = (bf16*)(wl + WO_WI2); ldk = DM; }
    else { r -= I_WI; W = in_ptr(F, 20) + (size_t)l * DFF * DM; ldn = DM; nrb = 64; WT = (bf16*)(wl + WO_WO2); ldk = DFF; }
    const int kb = r / nrb, rb = r - kb * nrb; int c0 = 32 * rb, nv = 32;
    if (mode == 1) { const int t = rb >> 3, w = rb & 7; c0 = w < 4 ? t * 128 + w * 32 : DFF + t * 128 + (w - 4) * 32; }
    else if (mode == 2) { const int d0 = 32 * rb; if (d0 < C_GM) c0 = d0; else if (d0 < C_GC) c0 = d0 + 18; else if (d0 == C_GC) { c0 = 5120; nv = 18; } else { c0 = 0; nv = 0; } }
    TrDesc d; d.W = W; d.WT = WT; d.r0 = (size_t)32 * rb; d.ldn = ldn; d.c0 = c0; d.nv = nv; d.k0 = 64 * kb; d.ldk = ldk; d.kofs = kofs; return d;
}
constexpr int FILL_A = 16384, FILL_B = 11264, FILL_C = 16384, FILL_L = FILL_A + FILL_B + FILL_C, TR_TOTAL = DEPTH * I_LAYER;
constexpr int NEED_WI1 = I_WI, NEED_WO1 = NEED_WI1 + I_WO, NEED_WIN = NEED_WO1 + I_WIN, NEED_WOUT = NEED_WIN + 2 * I_C1 + 2 * I_C2 + I_POOL + I_PA + I_PB + I_PC + I_WOUT, NEED_WI2 = NEED_WOUT + I_WI, NEED_WO2 = NEED_WI2 + I_WO;
static_assert(NEED_WO2 == I_LAYER, "item order");
constexpr int tr_pro_min() { int p = 0;
    for (int l = 0; l < DEPTH; ++l) { const int base = l * I_LAYER, cap = l * FILL_L;
        const int n1 = base + NEED_WI1 - cap, n2 = base + NEED_WIN - (cap + FILL_A), n3 = base + NEED_WI2 - (cap + FILL_A + FILL_B), n4 = base + NEED_WO2 - (cap + FILL_L);
        p = n1 > p ? n1 : p; p = n2 > p ? n2 : p; p = n3 > p ? n3 : p; p = n4 > p ? n4 : p; }
    return p; }
constexpr int TR_PRO = MK_FILLER ? tr_pro_min() : TR_TOTAL;
__device__ __forceinline__ void tr_run(const Frame& F, unsigned char* ws, int first, int end, int stride) {
    LAS float* scr = (LAS float*)(F.lds + RING_OFF + F.wave * 16384);
#define TR_DEC(g_) tr_decode(F, ws, (g_) / I_LAYER, (g_) % I_LAYER)
    int it = first;
    for (; it + stride < end; it += 2 * stride) { const TrDesc d0 = TR_DEC(it); const TrDesc d1 = TR_DEC(it + stride); tr_item2(d0, d1, scr, F.lane); }
    if (it < end) { const TrDesc d = TR_DEC(it); tr_item(d.W, d.ldn, d.c0, d.nv, d.k0, d.WT, d.r0, d.ldk, d.kofs, scr, F.lane); }
#undef TR_DEC
}
__device__ __forceinline__ void tr_filler(const Frame& F, int g0, int n, int first_idle) {
    if (F.bx < first_idle) return;
    const int g1 = g0 + n < TR_TOTAL ? g0 + n : TR_TOTAL;
    tr_run(F, ws_ptr(F), g0 + (F.bx - first_idle) * NWAVES + F.wave, g1, (F.G - first_idle) * NWAVES);
}
struct Args { const float* in[22]; float* out; unsigned char* ws; int ph_lo, ph_hi; };

__device__ __forceinline__ void rmsnorm_rows_bf16(const Frame& F, const float* src, const float* gain, bf16* dst) {
    for (int m = F.gw; m < MTOK; m += F.NGW) {
        const GAS f32x4* xr = (const GAS f32x4*)(src + (size_t)m * DM) + F.lane;
        f32x4 v[8]; float s = 0.f;
#pragma unroll
        for (int j = 0; j < 8; ++j) { v[j] = xr[64 * j]; s += (v[j].x * v[j].x + v[j].y * v[j].y) + (v[j].z * v[j].z + v[j].w * v[j].w); }
        const float r = 1.0f / sqrtf(wave_sum(s) * (1.0f / DM) + EPS);
        GAS unsigned long long* o8 = (GAS unsigned long long*)(dst + (size_t)m * DM) + F.lane;
#pragma unroll
        for (int j = 0; j < 8; ++j) { const f32x4 g = ((const GAS f32x4*)gain)[F.lane + 64 * j];
            o8[64 * j] = (unsigned long long)pk2(v[j].x * r * g.x, v[j].y * r * g.y) | ((unsigned long long)pk2(v[j].z * r * g.z, v[j].w * r * g.w) << 32); }
    }
}
__device__ __forceinline__ void rmsnorm_rows_f32(const Frame& F, const float* src, const float* gain, float* dst) {
    for (int m = F.gw; m < MTOK; m += F.NGW) {
        const GAS f32x4* xr = (const GAS f32x4*)(src + (size_t)m * DM) + F.lane;
        f32x4 v[8]; float s = 0.f;
#pragma unroll
        for (int j = 0; j < 8; ++j) { v[j] = xr[64 * j]; s += (v[j].x * v[j].x + v[j].y * v[j].y) + (v[j].z * v[j].z + v[j].w * v[j].w); }
        const float r = 1.0f / sqrtf(wave_sum(s) * (1.0f / DM) + EPS);
        GAS f32x4* o = (GAS f32x4*)(dst + (size_t)m * DM) + F.lane;
#pragma unroll
        for (int j = 0; j < 8; ++j) { const f32x4 g = ((const GAS f32x4*)gain)[F.lane + 64 * j]; o[64 * j] = v[j] * r * g; }
    }
}


namespace att {
typedef short bf16x8 __attribute__((ext_vector_type(8)));
constexpr int KP = 272;
constexpr int VP = 240;
__host__ __device__ constexpr int tile_bytes(int DH) { return 64 * KP + DH * VP; }
__device__ __forceinline__ int slotpos(int k) { return (k & 32) | (((k >> 2) & 3) << 3) | (((k >> 4) & 1) << 2) | (k & 3); }
constexpr float NEGB = -1e30f;

template <int DH, int NH, int KSPLIT, class P>
__device__ __forceinline__ void attn_unit(const Frame& F, const P& pol) {
    constexpr int NSLAB = 8 / KSPLIT, KS = DH / 32, DT = DH / 16, CPR = DH / 8  ;
    constexpr int KCH = (64 * CPR) / 512, VT = 32 * CPR, KBYTES = 64 * KP, TILE = tile_bytes(DH);
    static_assert(KCH >= 1 && VT <= 512 && KSPLIT * TILE <= RING_BYTES, "attention tile geometry");
    LAS unsigned char* const L = F.lds + RING_OFF;
    const int tid = F.tid, lane = F.lane, wave = F.wave, qi = lane & 15, qg = lane >> 4;
    const int slab = wave % NSLAB, kgrp = wave / NSLAB, iq = slab * 16 + qi;
    bf16x8 qf[NH][KS];
#pragma unroll
    for (int h = 0; h < NH; ++h)
#pragma unroll
        for (int ks = 0; ks < KS; ++ks) qf[h][ks] = *(const bf16x8*)(pol.qptr(iq, h) + ks * 32 + qg * 8);
    float m[NH], l[NH]; f32x4 o[NH][DT];
#pragma unroll
    for (int h = 0; h < NH; ++h) { m[h] = NEGB; l[h] = 0.f;
#pragma unroll
        for (int dt = 0; dt < DT; ++dt) o[h][dt] = (f32x4){0.f, 0.f, 0.f, 0.f}; }
    const int kt_lo = pol.kt_lo, kt_hi = pol.kt_hi, n_iter = (kt_hi - kt_lo + KSPLIT - 1) / KSPLIT;
    v4u kreg[KSPLIT][KCH], vreg[KSPLIT][2];
    const int vkp = tid & 31, vdc = tid >> 5;
#define ATT_PREFETCH(it_) do { _Pragma("unroll") for (int ts = 0; ts < KSPLIT; ++ts) { int kt_ = kt_lo + (it_) * KSPLIT + ts; kt_ = kt_ < kt_hi ? kt_ : kt_hi - 1; \
        _Pragma("unroll") for (int c = 0; c < KCH; ++c) { const int ch = tid + 512 * c; kreg[ts][c] = *(const v4u*)(pol.kptr(kt_ * 64 + ch / CPR) + (ch % CPR) * 8); } \
        if (VT == 512 || tid < VT) { vreg[ts][0] = *(const v4u*)(pol.vptr(kt_ * 64 + 2 * vkp) + vdc * 8); vreg[ts][1] = *(const v4u*)(pol.vptr(kt_ * 64 + 2 * vkp + 1) + vdc * 8); } } } while (0)
    ATT_PREFETCH(0);
    for (int it = 0; it < n_iter; ++it) {
        __syncthreads();
#pragma unroll
        for (int ts = 0; ts < KSPLIT; ++ts) { LAS unsigned char* base = L + ts * TILE;
#pragma unroll
            for (int c = 0; c < KCH; ++c) { const int ch = tid + 512 * c; *(LAS v4u*)(base + (ch / CPR) * KP + (ch % CPR) * 16) = kreg[ts][c]; }
            if (VT == 512 || tid < VT) { LAS unsigned char* vb = base + KBYTES + (vdc * 8) * VP + slotpos(2 * vkp) * 2; const v4u a = vreg[ts][0], b = vreg[ts][1];
                *(LAS unsigned*)(vb + 0 * VP) = (a.x & 0xffffu) | (b.x << 16); *(LAS unsigned*)(vb + 1 * VP) = (a.x >> 16) | (b.x & 0xffff0000u);
                *(LAS unsigned*)(vb + 2 * VP) = (a.y & 0xffffu) | (b.y << 16); *(LAS unsigned*)(vb + 3 * VP) = (a.y >> 16) | (b.y & 0xffff0000u);
                *(LAS unsigned*)(vb + 4 * VP) = (a.z & 0xffffu) | (b.z << 16); *(LAS unsigned*)(vb + 5 * VP) = (a.z >> 16) | (b.z & 0xffff0000u);
                *(LAS unsigned*)(vb + 6 * VP) = (a.w & 0xffffu) | (b.w << 16); *(LAS unsigned*)(vb + 7 * VP) = (a.w >> 16) | (b.w & 0xffff0000u); } }
        __syncthreads();
        if (it + 1 < n_iter) ATT_PREFETCH(it + 1);
        const int kt = kt_lo + it * KSPLIT + kgrp;
        if (kt < kt_hi && pol.wave_tile_active(kt)) {
            const LAS unsigned char* Kt = L + kgrp * TILE; const LAS unsigned char* Vt = Kt + KBYTES;
            bf16x8 pf[NH][2];
#pragma unroll
            for (int h = 0; h < NH; ++h) {
                f32x4 s[4];
#pragma unroll
                for (int nt = 0; nt < 4; ++nt) { s[nt] = (f32x4){0.f, 0.f, 0.f, 0.f};
#pragma unroll
                    for (int ks = 0; ks < KS; ++ks) { const bf16x8 kf = *(const LAS bf16x8*)(Kt + (nt * 16 + qi) * KP + (ks * 32 + qg * 8) * 2);
                        s[nt] = __builtin_amdgcn_mfma_f32_16x16x32_bf16(kf, qf[h][ks], s[nt], 0, 0, 0); } }
                float mx = NEGB;
#pragma unroll
                for (int nt = 0; nt < 4; ++nt)
#pragma unroll
                    for (int r = 0; r < 4; ++r) { const int k = kt * 64 + nt * 16 + qg * 4 + r; const float v = pol.valid(iq, k) ? s[nt][r] * P::SC : NEGB; s[nt][r] = v; mx = fmaxf(mx, v); }
                mx = fmaxf(mx, __shfl_xor(mx, 16)); mx = fmaxf(mx, __shfl_xor(mx, 32));
                const float mnew = fmaxf(m[h], mx), msafe = mnew <= NEGB ? 0.f : mnew;
                const float corr = __builtin_amdgcn_exp2f(m[h] - msafe); m[h] = mnew;
                float psum = 0.f;
#pragma unroll
                for (int nt = 0; nt < 4; ++nt)
#pragma unroll
                    for (int r = 0; r < 4; ++r) { const float p = __builtin_amdgcn_exp2f(s[nt][r] - msafe); s[nt][r] = p; psum += p; }
                l[h] = l[h] * corr + psum;
#pragma unroll
                for (int dt = 0; dt < DT; ++dt) o[h][dt] *= corr;
#pragma unroll
                for (int i = 0; i < 2; ++i) { v4u w; w.x = pg8::cvt_pk_bf16(s[2 * i][0], s[2 * i][1]); w.y = pg8::cvt_pk_bf16(s[2 * i][2], s[2 * i][3]);
                    w.z = pg8::cvt_pk_bf16(s[2 * i + 1][0], s[2 * i + 1][1]); w.w = pg8::cvt_pk_bf16(s[2 * i + 1][2], s[2 * i + 1][3]); pf[h][i] = __builtin_bit_cast(bf16x8, w); }
            }
#pragma unroll
            for (int dt = 0; dt < DT; ++dt)
#pragma unroll
                for (int i = 0; i < 2; ++i) { const bf16x8 vf = *(const LAS bf16x8*)(Vt + (dt * 16 + qi) * VP + (i * 32 + qg * 8) * 2);
#pragma unroll
                    for (int h = 0; h < NH; ++h) o[h][dt] = __builtin_amdgcn_mfma_f32_16x16x32_bf16(vf, pf[h][i], o[h][dt], 0, 0, 0); }
        }
    }
#undef ATT_PREFETCH
    if (KSPLIT == 2) {
        __syncthreads();
        LAS float* X = (LAS float*)L; constexpr int NV = DT * 4 + 2;
        if (kgrp == 1) {
#pragma unroll
            for (int h = 0; h < NH; ++h) { LAS float* xb = X + ((slab * NH + h) * NV) * 64 + lane; xb[0] = m[h]; xb[64] = l[h];
#pragma unroll
                for (int dt = 0; dt < DT; ++dt)
#pragma unroll
                    for (int r = 0; r < 4; ++r) xb[(2 + dt * 4 + r) * 64] = o[h][dt][r]; }
        }
        __syncthreads();
        if (kgrp == 0) {
#pragma unroll
            for (int h = 0; h < NH; ++h) { const LAS float* xb = X + ((slab * NH + h) * NV) * 64 + lane; const float mb = xb[0], lb = xb[64];
                const float mn = fmaxf(m[h], mb), ms = mn <= NEGB ? 0.f : mn; const float fa = __builtin_amdgcn_exp2f(m[h] - ms), fb = __builtin_amdgcn_exp2f(mb - ms);
                m[h] = mn; l[h] = l[h] * fa + lb * fb;
#pragma unroll
                for (int dt = 0; dt < DT; ++dt)
#pragma unroll
                    for (int r = 0; r < 4; ++r) o[h][dt][r] = o[h][dt][r] * fa + xb[(2 + dt * 4 + r) * 64] * fb; }
        }
    }
    if (kgrp == 0) {
#pragma unroll
        for (int h = 0; h < NH; ++h) { float lt = l[h]; lt += __shfl_xor(lt, 16); lt += __shfl_xor(lt, 32); const float inv = 1.0f / lt;
            if (qg == 0) pol.stats(iq, h, m[h], lt);
#pragma unroll
            for (int dt = 0; dt < DT; ++dt) pol.out4(iq, h, dt * 16 + qg * 4, o[h][dt] * inv); }
    }
    __syncthreads();
}

__device__ __forceinline__ void glds16(const void* gsrc, unsigned lds_dst) { unsigned keep;
    asm volatile("s_mov_b32 %0, m0\n\ts_mov_b32 m0, %2\n\ts_nop 0\n\tglobal_load_lds_dwordx4 %1, off\n\ts_mov_b32 m0, %0" : "=&s"(keep) : "v"(gsrc), "s"(lds_dst) : "memory"); }
template <int NH, class P>
__device__ __forceinline__ void attn_unit3(const Frame& F, const P& pol) {
    constexpr int KS = 4, DT = 8, TB = 16384, VBASE = 4 * TB;
    typedef short v4i16_t __attribute__((ext_vector_type(4)));
    LAS unsigned char* const L = F.lds + RING_OFF; const unsigned ldsaddr = (unsigned)(size_t)L;
    int tid_l = F.tid; asm volatile("" : "+v"(tid_l));
    const int tid = tid_l, lane = tid & 63, wave = __builtin_amdgcn_readfirstlane(tid >> 6), qi = lane & 15, qg = lane >> 4;
    const int slab = wave & 3, kgrp = wave >> 2, iq = slab * 16 + qi;
    const int rbq = ((qg & 1) << 3) | ((qg >> 1) << 2);
    const int krow = (((qi >> 2) & 1) << 3) | ((qi >> 3) << 2) | (qi & 3);
    bf16x8 qf[NH][KS];
#pragma unroll
    for (int h = 0; h < NH; ++h)
#pragma unroll
        for (int ks = 0; ks < KS; ++ks) qf[h][ks] = *(const bf16x8*)(pol.qptr(iq, h) + ks * 32 + qg * 8);
    float m[NH], l[NH]; f32x4 o[NH][DT];
#pragma unroll
    for (int h = 0; h < NH; ++h) { m[h] = NEGB; l[h] = 0.f;
#pragma unroll
        for (int dt = 0; dt < DT; ++dt) o[h][dt] = (f32x4){0.f, 0.f, 0.f, 0.f}; }
    const int kt_lo = pol.kt_lo, kt_hi = pol.kt_hi, n_iter = (kt_hi - kt_lo + 1) / 2;
    const int drow0 = wave * 8 + (lane >> 4), drow1 = drow0 + 4, cp = lane & 15;
    const int kc0 = (cp ^ (drow0 & 15)) * 8, kc1 = (cp ^ (drow1 & 15)) * 8;
    const int vc0 = (cp ^ (((drow0 & 3) << 2) | ((drow0 >> 2) & 3))) * 8, vc1 = (cp ^ (((drow1 & 3) << 2) | ((drow1 >> 2) & 3))) * 8;
#define ATT3_ISSUE(it_) do { _Pragma("unroll") for (int ts = 0; ts < 2; ++ts) { int kt_ = kt_lo + (it_) * 2 + ts; kt_ = kt_ < kt_hi ? kt_ : kt_hi - 1; \
        const unsigned dst_ = (unsigned)__builtin_amdgcn_readfirstlane((int)(ldsaddr + ((((it_) & 1) * 2 + ts) * TB) + wave * 2048)); \
        glds16(pol.kptr(kt_ * 64 + drow0) + kc0, dst_); glds16(pol.kptr(kt_ * 64 + drow1) + kc1, dst_ + 1024u); \
        glds16(pol.vptr(kt_ * 64 + drow0) + vc0, dst_ + VBASE); glds16(pol.vptr(kt_ * 64 + drow1) + vc1, dst_ + VBASE + 1024u); } } while (0)
    const int kbase = krow * 256;
    const int vq = qi >> 2, vp = qi & 3, vsw = (vq << 2) | ((rbq >> 2) & 3);
    const int vrowb = (rbq + vq) * 256 + 8 * (vp & 1), vph = vp >> 1;
    __syncthreads();
    ATT3_ISSUE(0);
    for (int it = 0; it < n_iter; ++it) {
        asm volatile("s_waitcnt vmcnt(0)" ::: "memory");
        __syncthreads();
        if (it + 1 < n_iter) ATT3_ISSUE(it + 1);
        const int kt = kt_lo + it * 2 + kgrp;
        if (kt < kt_hi && pol.wave_tile_active(kt)) {
            const LAS unsigned char* Kt = L + ((it & 1) * 2 + kgrp) * TB; const LAS unsigned char* Vt = Kt + VBASE;
            bf16x8 pf[NH][2];
#pragma unroll
            for (int h = 0; h < NH; ++h) {
                f32x4 s[4];
#pragma unroll
                for (int nt = 0; nt < 4; ++nt) { s[nt] = (f32x4){0.f, 0.f, 0.f, 0.f};
#pragma unroll
                    for (int ks = 0; ks < KS; ++ks) { const bf16x8 kf = *(const LAS bf16x8*)(Kt + nt * 4096 + kbase + (((ks * 4 + qg) ^ krow) * 16));
                        s[nt] = __builtin_amdgcn_mfma_f32_16x16x32_bf16(kf, qf[h][ks], s[nt], 0, 0, 0); } }
                float mx = NEGB;
#pragma unroll
                for (int nt = 0; nt < 4; ++nt)
#pragma unroll
                    for (int r = 0; r < 4; ++r) { const int k = kt * 64 + nt * 16 + rbq + r; const float v = pol.valid(iq, k) ? s[nt][r] * P::SC : NEGB; s[nt][r] = v; mx = fmaxf(mx, v); }
                mx = fmaxf(mx, __shfl_xor(mx, 16)); mx = fmaxf(mx, __shfl_xor(mx, 32));
                const float mnew = fmaxf(m[h], mx), msafe = mnew <= NEGB ? 0.f : mnew;
                const float corr = __builtin_amdgcn_exp2f(m[h] - msafe); m[h] = mnew;
                float psum = 0.f;
#pragma unroll
                for (int nt = 0; nt < 4; ++nt)
#pragma unroll
                    for (int r = 0; r < 4; ++r) { const float p = __builtin_amdgcn_exp2f(s[nt][r] - msafe); s[nt][r] = p; psum += p; }
                l[h] = l[h] * corr + psum;
#pragma unroll
                for (int dt = 0; dt < DT; ++dt) o[h][dt] *= corr;
#pragma unroll
                for (int i = 0; i < 2; ++i) { v4u w; w.x = pg8::cvt_pk_bf16(s[2 * i][0], s[2 * i][1]); w.y = pg8::cvt_pk_bf16(s[2 * i][2], s[2 * i][3]);
                    w.z = pg8::cvt_pk_bf16(s[2 * i + 1][0], s[2 * i + 1][1]); w.w = pg8::cvt_pk_bf16(s[2 * i + 1][2], s[2 * i + 1][3]); pf[h][i] = __builtin_bit_cast(bf16x8, w); }
            }
#pragma unroll
            for (int dt = 0; dt < DT; ++dt) { const LAS unsigned char* vrd = Vt + vrowb + ((((2 * dt) ^ (vsw & 14)) | (vph ^ (vsw & 1))) * 16);
#pragma unroll
                for (int i = 0; i < 2; ++i) {
                    const v4i16_t lo = __builtin_amdgcn_ds_read_tr16_b64_v4i16((LAS v4i16_t*)(vrd + i * 8192)), hi = __builtin_amdgcn_ds_read_tr16_b64_v4i16((LAS v4i16_t*)(vrd + i * 8192 + 4096));
                    const bf16x8 vf = (bf16x8){lo[0], lo[1], lo[2], lo[3], hi[0], hi[1], hi[2], hi[3]};
#pragma unroll
                    for (int h = 0; h < NH; ++h) o[h][dt] = __builtin_amdgcn_mfma_f32_16x16x32_bf16(vf, pf[h][i], o[h][dt], 0, 0, 0); } }
        }
    }
#undef ATT3_ISSUE
    {
        __syncthreads();
        LAS float* X = (LAS float*)L; constexpr int NV = DT * 4 + 2;
        if (kgrp == 1) {
#pragma unroll
            for (int h = 0; h < NH; ++h) { LAS float* xb = X + ((slab * NH + h) * NV) * 64 + lane; xb[0] = m[h]; xb[64] = l[h];
#pragma unroll
                for (int dt = 0; dt < DT; ++dt)
#pragma unroll
                    for (int r = 0; r < 4; ++r) xb[(2 + dt * 4 + r) * 64] = o[h][dt][r]; }
        }
        __syncthreads();
        if (kgrp == 0) {
#pragma unroll
            for (int h = 0; h < NH; ++h) { const LAS float* xb = X + ((slab * NH + h) * NV) * 64 + lane; const float mb = xb[0], lb = xb[64];
                const float mn = fmaxf(m[h], mb), ms = mn <= NEGB ? 0.f : mn; const float fa = __builtin_amdgcn_exp2f(m[h] - ms), fb = __builtin_amdgcn_exp2f(mb - ms);
                m[h] = mn; l[h] = l[h] * fa + lb * fb;
#pragma unroll
                for (int dt = 0; dt < DT; ++dt)
#pragma unroll
                    for (int r = 0; r < 4; ++r) o[h][dt][r] = o[h][dt][r] * fa + xb[(2 + dt * 4 + r) * 64] * fb; }
        }
    }
    if (kgrp == 0) {
#pragma unroll
        for (int h = 0; h < NH; ++h) { float lt = l[h]; lt += __shfl_xor(lt, 16); lt += __shfl_xor(lt, 32); const float inv = 1.0f / lt;
            if (qg == 0) pol.stats(iq, h, m[h], lt);
#pragma unroll
            for (int dt = 0; dt < DT; ++dt) pol.out4(iq, h, dt * 16 + qg * 4, o[h][dt] * inv); }
    }
    __syncthreads();
}

constexpr float SC128 = 0.08838834764831845f * 1.4426950408889634f, SC64 = 0.125f * 1.4426950408889634f, LN2 = 0.6931471805599453f;
struct SlcPol {
    static constexpr float SC = SC128;
    const bf16* COLS; const float* OC; const float* OW; bf16* BR; int b, g, qt, h0, kt_lo, kt_hi; unsigned mask; float gate[3];
    __device__ __forceinline__ void init(unsigned char* ws, int b_, int g_, int qt_, int iq, int h0_ = 0) { h0 = h0_;
        COLS = (const bf16*)(ws + WS_COLS); OC = (const float*)(ws + WS_OC); OW = (const float*)(ws + WS_OW); BR = (bf16*)(ws + WS_BR); b = b_; g = g_; qt = qt_; kt_lo = 0; kt_hi = qt_ + 1;
        const int row = b * SEQ + qt * 64 + iq; mask = ((const unsigned*)(ws + WS_SEL))[row * 2 + g];
#pragma unroll
        for (int h = 0; h < 3; ++h) gate[h] = bf2f(COLS[(size_t)row * NCOLS + C_GC + (g * 3 + (h + h0_ > 2 ? 2 : h + h0_)) * 3 + 1]);
    }
    __device__ __forceinline__ const bf16* qptr(int iq, int h) const { return COLS + (size_t)(b * SEQ + qt * 64 + iq) * NCOLS + C_QC + (g * 3 + h0 + h) * 128; }
    __device__ __forceinline__ const bf16* kptr(int k) const { return COLS + (size_t)(b * SEQ + k) * NCOLS + C_KSLC + g * 128; }
    __device__ __forceinline__ const bf16* vptr(int k) const { return COLS + (size_t)(b * SEQ + k) * NCOLS + C_VSLC + g * 128; }
    __device__ __forceinline__ bool wave_tile_active(int kt) const { return __any((int)((mask >> kt) & 1u)) != 0; }
    __device__ __forceinline__ bool valid(int iq, int k) const { return ((mask >> (k >> 6)) & 1u) && k <= qt * 64 + iq; }
    __device__ __forceinline__ void stats(int, int, float, float) const {}
    __device__ __forceinline__ void out4(int iq, int h, int d, f32x4 v) const {
        const size_t off = (size_t)(b * SEQ + qt * 64 + iq) * 768 + (g * 3 + h0 + h) * 128 + d; const f32x4 c = *(const f32x4*)(OC + off), w = *(const f32x4*)(OW + off); const f32x4 t = c + w + v * gate[h];
        *(unsigned long long*)(BR + (size_t)(b * SEQ + qt * 64 + iq) * NBR + 768 + (g * 3 + h0 + h) * 128 + d) = (unsigned long long)pk2(t.x, t.y) | ((unsigned long long)pk2(t.z, t.w) << 32);
    }
};
struct WinPol {
    static constexpr float SC = SC128;
    const bf16* COLS; float* OW; int b, g, qt, h0, kt_lo, kt_hi; float gate[3];
    __device__ __forceinline__ void init(unsigned char* ws, int b_, int g_, int qt_, int iq, int h0_ = 0) { h0 = h0_;
        COLS = (const bf16*)(ws + WS_COLS); OW = (float*)(ws + WS_OW); b = b_; g = g_; qt = qt_; kt_lo = qt_ > 8 ? qt_ - 8 : 0; kt_hi = qt_ + 1;
        const int row = b * SEQ + qt * 64 + iq;
#pragma unroll
        for (int h = 0; h < 3; ++h) gate[h] = bf2f(COLS[(size_t)row * NCOLS + C_GC + (g * 3 + (h + h0_ > 2 ? 2 : h + h0_)) * 3 + 2]);
    }
    __device__ __forceinline__ const bf16* qptr(int iq, int h) const { return COLS + (size_t)(b * SEQ + qt * 64 + iq) * NCOLS + C_QC + (g * 3 + h0 + h) * 128; }
    __device__ __forceinline__ const bf16* kptr(int k) const { return COLS + (size_t)(b * SEQ + k) * NCOLS + C_KWIN + g * 128; }
    __device__ __forceinline__ const bf16* vptr(int k) const { return COLS + (size_t)(b * SEQ + k) * NCOLS + C_VWIN + g * 128; }
    __device__ __forceinline__ bool wave_tile_active(int) const { return true; }
    __device__ __forceinline__ bool valid(int iq, int k) const { const int t = qt * 64 + iq; return k <= t && k > t - 512; }
    __device__ __forceinline__ void stats(int, int, float, float) const {}
    __device__ __forceinline__ void out4(int iq, int h, int d, f32x4 v) const { *(f32x4*)(OW + (size_t)(b * SEQ + qt * 64 + iq) * 768 + (g * 3 + h0 + h) * 128 + d) = v * gate[h]; }
};
struct DilPol {
    static constexpr float SC = SC64;
    const bf16* COLS; float* OG; float* LSE; int b, gi, hh, r, qb, dil, kt_lo, kt_hi;
    __device__ __forceinline__ void init(unsigned char* ws, int b_, int gi_, int h_, int r_, int qb_) {
        COLS = (const bf16*)(ws + WS_COLS); OG = (float*)(ws + WS_OG); LSE = (float*)(ws + WS_LSE); b = b_; gi = gi_; hh = h_; r = r_; qb = qb_; dil = 1 << (2 * gi_);
        const int nt = (SEQ / dil) / 64; kt_lo = 2 * qb_ - 2 > 0 ? 2 * qb_ - 2 : 0; kt_hi = 2 * qb_ + 2 < nt ? 2 * qb_ + 2 : nt;
    }
    __device__ __forceinline__ int row(int iq) const { return b * SEQ + r + (qb * 128 + iq) * dil; }
    __device__ __forceinline__ const bf16* qptr(int iq, int) const { return COLS + (size_t)row(iq) * NCOLS + C_QA + (gi * 4 + hh) * 64; }
    __device__ __forceinline__ const bf16* kptr(int k) const { return COLS + (size_t)(b * SEQ + r + k * dil) * NCOLS + C_KA + (gi * 4 + hh) * 64; }
    __device__ __forceinline__ const bf16* vptr(int k) const { return COLS + (size_t)(b * SEQ + r + k * dil) * NCOLS + C_VA + (gi * 4 + hh) * 64; }
    __device__ __forceinline__ bool wave_tile_active(int) const { return true; }
    __device__ __forceinline__ bool valid(int iq, int k) const { const int i = qb * 128 + iq; return k <= i && k >= i - 128; }
    __device__ __forceinline__ void stats(int iq, int, float mm, float lt) const { LSE[((size_t)gi * MTOK + row(iq)) * 4 + hh] = mm * LN2 + __logf(lt); }
    __device__ __forceinline__ void out4(int iq, int, int d, f32x4 v) const { *(f32x4*)(OG + ((size_t)gi * MTOK + row(iq)) * 256 + hh * 64 + d) = v; }
};
}

namespace mixu {
using att::bf16x8; using att::KP; using att::VP;
__device__ __forceinline__ float gelu_tanh_f(float x) { const float y = 0.7978845608028654f * (x + 0.044715f * x * x * x); const float t = 1.0f - 2.0f / (1.0f + __expf(2.0f * y)); return 0.5f * x * (1.0f + t); }

__device__ __forceinline__ void compress_unit(const Frame& F, unsigned char* ws, int l, int unit, const float* pe_k, const float* pe_v) {
    const int kv = unit & 1, cch = (unit >> 1) & 7, bg = unit >> 4, b = bg >> 1, g = bg & 1, c0 = cch * 16;
    const bf16* COLS = (const bf16*)(ws + WS_COLS); unsigned char* wl = ws + WS_W + (size_t)l * W_LAYER;
    const bf16* W1T = (const bf16*)(wl + (kv ? WO_C1V : WO_C1K)); const bf16* W2T = (const bf16*)(wl + (kv ? WO_C2V : WO_C2K)); const float* pe = kv ? pe_v : pe_k;
    const int lane = F.lane, w = F.wave, qi = lane & 15, qg = lane >> 4, col0 = (kv ? C_VCMP : C_KCMP) + g * 128;
    int cc = c0 + qi; cc = cc > 126 ? 126 : cc;
    const bf16* xrow = COLS + (size_t)(b * SEQ + 16 * cc) * NCOLS + col0;
    f32x4 acc[8];
#pragma unroll
    for (int nt = 0; nt < 8; ++nt) acc[nt] = (f32x4){0.f, 0.f, 0.f, 0.f};
#pragma unroll 4
    for (int ks = 0; ks < 16; ++ks) { const int k = w * 512 + ks * 32 + qg * 8, j = k >> 7, d = k & 127;
        float x[8]; load8(xrow + (size_t)j * NCOLS + d, x); const f32x4 p0 = *(const f32x4*)(pe + k), p1 = *(const f32x4*)(pe + k + 4);
        v4u xw; xw.x = pg8::cvt_pk_bf16(x[0] + p0.x, x[1] + p0.y); xw.y = pg8::cvt_pk_bf16(x[2] + p0.z, x[3] + p0.w); xw.z = pg8::cvt_pk_bf16(x[4] + p1.x, x[5] + p1.y); xw.w = pg8::cvt_pk_bf16(x[6] + p1.z, x[7] + p1.w);
        const bf16x8 xb = __builtin_bit_cast(bf16x8, xw);
#pragma unroll
        for (int nt = 0; nt < 8; ++nt) { const bf16x8 wf = *(const bf16x8*)(W1T + (size_t)(nt * 16 + qi) * 4096 + k); acc[nt] = __builtin_amdgcn_mfma_f32_16x16x32_bf16(wf, xb, acc[nt], 0, 0, 0); } }
    LAS float* Pp = (LAS float*)(F.lds + RING_OFF);
    LAS unsigned char* G = F.lds + RING_OFF + 65536;
    __syncthreads();
#pragma unroll
    for (int nt = 0; nt < 8; ++nt)
#pragma unroll
        for (int r = 0; r < 4; ++r) Pp[(w * 128 + nt * 16 + 4 * qg + r) * 16 + qi] = acc[nt][r];
    __syncthreads();
#pragma unroll
    for (int j = 0; j < 4; ++j) { const int e = F.tid + 512 * j, n = e >> 4, c = e & 15; float s = 0.f;
#pragma unroll
        for (int ww = 0; ww < 8; ++ww) s += Pp[(ww * 128 + n) * 16 + c];
        *(LAS unsigned short*)(G + c * KP + n * 2) = (unsigned short)f2bf(gelu_tanh_f(s)); }
    __syncthreads();
    f32x4 o = {0.f, 0.f, 0.f, 0.f};
#pragma unroll
    for (int ks = 0; ks < 4; ++ks) { const bf16x8 wf = *(const bf16x8*)(W2T + (size_t)(w * 16 + qi) * 128 + ks * 32 + qg * 8); const bf16x8 gf = *(const LAS bf16x8*)(G + qi * KP + (ks * 32 + qg * 8) * 2);
        o = __builtin_amdgcn_mfma_f32_16x16x32_bf16(wf, gf, o, 0, 0, 0); }
    bf16* dst = (bf16*)(ws + (kv ? WS_VC : WS_KC)) + (size_t)(bg * 128 + c0 + qi) * 128 + w * 16 + 4 * qg;
    const bool real = c0 + qi < 127;
    *(unsigned long long*)dst = real ? ((unsigned long long)pk2(o[0], o[1]) | ((unsigned long long)pk2(o[2], o[3]) << 32)) : 0ull;
    __syncthreads();
}

template <int GI>
__device__ __forceinline__ void pool_unit_t(const Frame& F, unsigned char* ws, int l, int blk, const float* pscale) {
    constexpr int WIN = 2 << GI;
    int tid_l = F.tid; asm volatile("" : "+v"(tid_l));
    const int lane = tid_l & 63, w = __builtin_amdgcn_readfirstlane(tid_l >> 6), qi = lane & 15, qg = lane >> 4;
    const bf16* COLS = (const bf16*)(ws + WS_COLS); const bf16* PT = (const bf16*)(ws + WS_W + (size_t)l * W_LAYER + WO_POOL) + GI * 16384;
    const int row = blk * 32 + (w >> 2) * 16 + qi, s = row & (SEQ - 1); const int cnt = s + 1 < WIN ? s + 1 : WIN; const float rc = 1.0f / (float)cnt;
    const bf16* xr = COLS + (size_t)row * NCOLS + C_XB + GI * 128;
    f32x4 acc[8];
#pragma unroll
    for (int nt = 0; nt < 8; ++nt) acc[nt] = (f32x4){0.f, 0.f, 0.f, 0.f};
#pragma unroll
    for (int ks = 0; ks < 4; ++ks) { const int c = ks * 32 + qg * 8; v4u xw[WIN];
#pragma unroll
        for (int j = 0; j < WIN; ++j) xw[j] = *(const v4u*)(xr - (ptrdiff_t)(j < cnt ? j : 0) * NCOLS + c);
        float sum[8];
#pragma unroll
        for (int e = 0; e < 8; ++e) sum[e] = 0.f;
#pragma unroll
        for (int j = 0; j < WIN; ++j) { const float mk = j < cnt ? 1.f : 0.f; const v4u q = xw[j];
            sum[0] += mk * pg8::bflo(q.x); sum[1] += mk * pg8::bfhi(q.x); sum[2] += mk * pg8::bflo(q.y); sum[3] += mk * pg8::bfhi(q.y);
            sum[4] += mk * pg8::bflo(q.z); sum[5] += mk * pg8::bfhi(q.z); sum[6] += mk * pg8::bflo(q.w); sum[7] += mk * pg8::bfhi(q.w); }
        const v4u q0 = xw[0];
        v4u pw; pw.x = pg8::cvt_pk_bf16(sum[0] * rc - pg8::bflo(q0.x), sum[1] * rc - pg8::bfhi(q0.x)); pw.y = pg8::cvt_pk_bf16(sum[2] * rc - pg8::bflo(q0.y), sum[3] * rc - pg8::bfhi(q0.y));
        pw.z = pg8::cvt_pk_bf16(sum[4] * rc - pg8::bflo(q0.z), sum[5] * rc - pg8::bfhi(q0.z)); pw.w = pg8::cvt_pk_bf16(sum[6] * rc - pg8::bflo(q0.w), sum[7] * rc - pg8::bfhi(q0.w));
        const bf16x8 pb = __builtin_bit_cast(bf16x8, pw);
#pragma unroll
        for (int nt = 0; nt < 8; ++nt) { const bf16x8 wf = *(const bf16x8*)(PT + (size_t)(nt * 16 + qi) * 128 + c); acc[nt] = __builtin_amdgcn_mfma_f32_16x16x32_bf16(wf, pb, acc[nt], 0, 0, 0); } }
    bf16* dst = (bf16*)(ws + WS_BR) + (size_t)row * NBR + 256 + GI * 128 + 4 * qg;
#pragma unroll
    for (int nt = 0; nt < 8; ++nt) { const f32x4 sc = *(const f32x4*)(pscale + GI * 128 + nt * 16 + 4 * qg); const f32x4 v = acc[nt] * sc;
        *(unsigned long long*)(dst + nt * 16) = (unsigned long long)pk2(v.x, v.y) | ((unsigned long long)pk2(v.z, v.w) << 32); }
}
__device__ __forceinline__ void pool_unit(const Frame& F, unsigned char* ws, int l, int unit, const float* pscale) {
    const int gi = F.wave & 3, blk = unit;
    if (gi == 0) pool_unit_t<0>(F, ws, l, blk, pscale); else if (gi == 1) pool_unit_t<1>(F, ws, l, blk, pscale); else if (gi == 2) pool_unit_t<2>(F, ws, l, blk, pscale); else pool_unit_t<3>(F, ws, l, blk, pscale);
}

__device__ __forceinline__ void cmp_unit(const Frame& F, unsigned char* ws, int unit) {
    constexpr int KBYTES = 64 * KP, TILE = att::tile_bytes(128), SCO = 2 * TILE;
    static_assert(SCO + 128 * 33 * 4 <= RING_BYTES, "cmp unit LDS");
    const int qb = unit & 15, bg = unit >> 4, b = bg >> 1, g = bg & 1;
    const bf16* COLS = (const bf16*)(ws + WS_COLS); const bf16* KC = (const bf16*)(ws + WS_KC) + (size_t)bg * 16384; const bf16* VC = (const bf16*)(ws + WS_VC) + (size_t)bg * 16384;
    float* OC = (float*)(ws + WS_OC); unsigned* SEL = (unsigned*)(ws + WS_SEL);
    LAS unsigned char* const L = F.lds + RING_OFF;
    const int tid = F.tid, lane = F.lane, w = F.wave, qi = lane & 15, qg = lane >> 4, iq = w * 16 + qi, t = qb * 128 + iq, row = b * SEQ + t;
    __syncthreads();
    {
        const int vkp = tid & 31, vdc = tid >> 5;
#pragma unroll
        for (int ts = 0; ts < 2; ++ts) { LAS unsigned char* base = L + ts * TILE;
#pragma unroll
            for (int c = 0; c < 2; ++c) { const int ch = tid + 512 * c; *(LAS v4u*)(base + (ch >> 4) * KP + (ch & 15) * 16) = *(const v4u*)(KC + (size_t)(ts * 64 + (ch >> 4)) * 128 + (ch & 15) * 8); }
            const v4u a = *(const v4u*)(VC + (size_t)(ts * 64 + 2 * vkp) * 128 + vdc * 8), bb = *(const v4u*)(VC + (size_t)(ts * 64 + 2 * vkp + 1) * 128 + vdc * 8);
            LAS unsigned char* vb = base + KBYTES + (vdc * 8) * VP + att::slotpos(2 * vkp) * 2;
            *(LAS unsigned*)(vb + 0 * VP) = (a.x & 0xffffu) | (bb.x << 16); *(LAS unsigned*)(vb + 1 * VP) = (a.x >> 16) | (bb.x & 0xffff0000u);
            *(LAS unsigned*)(vb + 2 * VP) = (a.y & 0xffffu) | (bb.y << 16); *(LAS unsigned*)(vb + 3 * VP) = (a.y >> 16) | (bb.y & 0xffff0000u);
            *(LAS unsigned*)(vb + 4 * VP) = (a.z & 0xffffu) | (bb.z << 16); *(LAS unsigned*)(vb + 5 * VP) = (a.z >> 16) | (bb.z & 0xffff0000u);
            *(LAS unsigned*)(vb + 6 * VP) = (a.w & 0xffffu) | (bb.w << 16); *(LAS unsigned*)(vb + 7 * VP) = (a.w >> 16) | (bb.w & 0xffff0000u); }
    }
    __syncthreads();
    f32x4 ph[2][4];
#pragma unroll
    for (int ts = 0; ts < 2; ++ts)
#pragma unroll
        for (int nt = 0; nt < 4; ++nt) ph[ts][nt] = (f32x4){0.f, 0.f, 0.f, 0.f};
#pragma unroll 1
    for (int h = 0; h < 3; ++h) {
        bf16x8 qf[4];
#pragma unroll
        for (int ks = 0; ks < 4; ++ks) qf[ks] = *(const bf16x8*)(COLS + (size_t)row * NCOLS + C_QC + (g * 3 + h) * 128 + ks * 32 + qg * 8);
        f32x4 s[2][4]; float mx = att::NEGB;
#pragma unroll
        for (int ts = 0; ts < 2; ++ts)
#pragma unroll
            for (int nt = 0; nt < 4; ++nt) { s[ts][nt] = (f32x4){0.f, 0.f, 0.f, 0.f};
#pragma unroll
                for (int ks = 0; ks < 4; ++ks) { const bf16x8 kf = *(const LAS bf16x8*)(L + ts * TILE + (nt * 16 + qi) * KP + (ks * 32 + qg * 8) * 2); s[ts][nt] = __builtin_amdgcn_mfma_f32_16x16x32_bf16(kf, qf[ks], s[ts][nt], 0, 0, 0); }
#pragma unroll
                for (int r = 0; r < 4; ++r) { const int c = ts * 64 + nt * 16 + qg * 4 + r; const float v = (c * 16 + 31 <= t && c <= 126) ? s[ts][nt][r] * att::SC128 : att::NEGB; s[ts][nt][r] = v; mx = fmaxf(mx, v); } }
        mx = fmaxf(mx, __shfl_xor(mx, 16)); mx = fmaxf(mx, __shfl_xor(mx, 32));
        const float msafe = mx <= att::NEGB ? 0.f : mx; float psum = 0.f;
#pragma unroll
        for (int ts = 0; ts < 2; ++ts)
#pragma unroll
            for (int nt = 0; nt < 4; ++nt)
#pragma unroll
                for (int r = 0; r < 4; ++r) { const float p = __builtin_amdgcn_exp2f(s[ts][nt][r] - msafe); s[ts][nt][r] = p; psum += p; }
        psum += __shfl_xor(psum, 16); psum += __shfl_xor(psum, 32);
        const float inv = psum > 0.f ? 1.0f / psum : 0.f;
        f32x4 o[8];
#pragma unroll
        for (int dt = 0; dt < 8; ++dt) o[dt] = (f32x4){0.f, 0.f, 0.f, 0.f};
#pragma unroll
        for (int ts = 0; ts < 2; ++ts) {
#pragma unroll
            for (int nt = 0; nt < 4; ++nt) { s[ts][nt] *= inv; ph[ts][nt] += s[ts][nt]; }
#pragma unroll
            for (int i = 0; i < 2; ++i) { v4u pw; pw.x = pg8::cvt_pk_bf16(s[ts][2 * i][0], s[ts][2 * i][1]); pw.y = pg8::cvt_pk_bf16(s[ts][2 * i][2], s[ts][2 * i][3]);
                pw.z = pg8::cvt_pk_bf16(s[ts][2 * i + 1][0], s[ts][2 * i + 1][1]); pw.w = pg8::cvt_pk_bf16(s[ts][2 * i + 1][2], s[ts][2 * i + 1][3]); const bf16x8 pf = __builtin_bit_cast(bf16x8, pw);
#pragma unroll
                for (int dt = 0; dt < 8; ++dt) { const bf16x8 vf = *(const LAS bf16x8*)(L + ts * TILE + KBYTES + (dt * 16 + qi) * VP + (i * 32 + qg * 8) * 2); o[dt] = __builtin_amdgcn_mfma_f32_16x16x32_bf16(vf, pf, o[dt], 0, 0, 0); } } }
        const float gate = bf2f(COLS[(size_t)row * NCOLS + C_GC + (g * 3 + h) * 3 + 0]);
#pragma unroll
        for (int dt = 0; dt < 8; ++dt) *(f32x4*)(OC + (size_t)row * 768 + (g * 3 + h) * 128 + dt * 16 + qg * 4) = o[dt] * gate;
    }
    float imp[2][4], y[2][4];
#pragma unroll
    for (int ts = 0; ts < 2; ++ts)
#pragma unroll
        for (int nt = 0; nt < 4; ++nt) { imp[ts][nt] = (ph[ts][nt][0] + ph[ts][nt][1]) + (ph[ts][nt][2] + ph[ts][nt][3]); y[ts][nt] = __shfl(ph[ts][nt][3], (lane + 48) & 63); }
    LAS float* SC = (LAS float*)(L + SCO) + iq * 33; const int tb = t >> 6;
#pragma unroll
    for (int ts = 0; ts < 2; ++ts)
#pragma unroll
        for (int nt = 0; nt < 4; ++nt) { const float yp = nt > 0 ? y[ts][nt - 1] : (ts > 0 ? y[ts - 1][3] : 0.f); const float prev = qg > 0 ? y[ts][nt] : yp;
            const int j = 16 * ts + 4 * nt + qg; const bool forced = (j == 0) || (j == tb) || (j == tb - 1);
            const float sc = j > tb ? -1.0f : (imp[ts][nt] + prev) + (forced ? 100.0f : 0.0f); imp[ts][nt] = sc; SC[j] = sc; }
    LDS_WAIT(); asm volatile("" ::: "memory");
    unsigned bits = 0u;
    int rank[2][4];
#pragma unroll
    for (int ts = 0; ts < 2; ++ts)
#pragma unroll
        for (int nt = 0; nt < 4; ++nt) rank[ts][nt] = 0;
    for (int i = 0; i < 32; ++i) { const float si = SC[i];
#pragma unroll
        for (int ts = 0; ts < 2; ++ts)
#pragma unroll
            for (int nt = 0; nt < 4; ++nt) { const int j = 16 * ts + 4 * nt + qg; rank[ts][nt] += (si > imp[ts][nt] || (si == imp[ts][nt] && i < j)) ? 1 : 0; } }
#pragma unroll
    for (int ts = 0; ts < 2; ++ts)
#pragma unroll
        for (int nt = 0; nt < 4; ++nt) if (rank[ts][nt] < 8) bits |= 1u << (16 * ts + 4 * nt + qg);
    bits |= (unsigned)__shfl_xor((int)bits, 16); bits |= (unsigned)__shfl_xor((int)bits, 32);
    if (qg == 0) SEL[row * 2 + g] = bits;
    __syncthreads();
}
}
__device__ __forceinline__ void mix_phase_a(const Frame& F, int l) {
    unsigned char* ws = ws_ptr(F);
    const bf16* COLS = (const bf16*)(ws + WS_COLS);
    const int lane = F.lane;
    for (int rep = 0; rep < 1 + ((PROBE_SUB >> 0) & 1); ++rep)
    for (int j = 0; j < 256; ++j) {
        int u; if (F.G == 256) { if (j > 1 || F.bx >= 128) break; u = F.bx + 128 * j; } else { u = F.bx + j * F.G; if (u >= 256) break; }
        att::WinPol pol; pol.init(ws, u >> 6, (u >> 5) & 1, u & 31, (F.wave & 3) * 16 + (lane & 15), 0); att::attn_unit3<2>(F, pol); }
    for (int rep = 0; rep < 1 + ((PROBE_SUB >> 1) & 1); ++rep)
    for (int u = F.bx; u < 768; u += F.G) { const int gi = u >> 8, v = u & 255, rest = v & 15; att::DilPol pol;
        pol.init(ws, v >> 6, gi, (v >> 4) & 3, gi == 0 ? 0 : (gi == 1 ? rest >> 2 : rest), gi == 0 ? rest : (gi == 1 ? rest & 3 : 0)); att::attn_unit<64, 1, 1>(F, pol); }
    { const float* pek = in_ptr(F, 8) + (size_t)l * 4096; const float* pev = in_ptr(F, 11) + (size_t)l * 4096;
      for (int rep = 0; rep < 1 + ((PROBE_SUB >> 2) & 1); ++rep)
      for (int u = F.bx; u < 256; u += F.G) { const int uu = (u + 128) & 255; if (uu < 128) mixu::compress_unit(F, ws, l, uu, pek, pev); } }
    { const float* psc = in_ptr(F, 7) + (size_t)l * 512; for (int rep = 0; rep < 1 + ((PROBE_SUB >> 3) & 1); ++rep) for (int u = F.bx; u < 256; u += F.G) mixu::pool_unit(F, ws, l, u, psc); }
}

__device__ __forceinline__ void mix_phase_b(const Frame& F) {
    unsigned char* ws = ws_ptr(F); const int lane = F.lane;
    for (int j = 0; j < 128; ++j) { int u; if (F.G == 256) { if (j > 0 || F.bx >= 128) break; u = F.bx; } else { u = F.bx + j * F.G; if (u >= 128) break; } mixu::cmp_unit(F, ws, u); }
    for (int j = 0; j < 256; ++j) { int u; if (F.G == 256) { if (j > 1 || F.bx < 128) break; u = (F.bx - 128) + 128 * j; } else { u = F.bx + j * F.G; if (u >= 256) break; }
        att::WinPol pol; pol.init(ws, u >> 6, (u >> 5) & 1, u & 31, (F.wave & 3) * 16 + (lane & 15), 2); att::attn_unit3<1>(F, pol); }
    {
        const float* OG = (const float*)(ws + WS_OG); const float* LSE = (const float*)(ws + WS_LSE); bf16* BR = (bf16*)(ws + WS_BR);
        const bool half = F.G == 256; const int gw = half ? (F.bx - 128) * NWAVES + F.wave : F.bx * NWAVES + F.wave, ngw = half ? 128 * NWAVES : F.G * NWAVES;
        if (!half || F.bx >= 128)
        for (int row = gw; row < MTOK; row += ngw) {
            const int h = lane >> 4;
            const float l0 = LSE[((size_t)0 * MTOK + row) * 4 + h], l1 = LSE[((size_t)1 * MTOK + row) * 4 + h], l2 = LSE[((size_t)2 * MTOK + row) * 4 + h];
            const float mx = fmaxf(l0, fmaxf(l1, l2)); float w0 = __expf(l0 - mx), w1 = __expf(l1 - mx), w2 = __expf(l2 - mx); const float inv = 1.0f / (w0 + w1 + w2); w0 *= inv; w1 *= inv; w2 *= inv;
            const f32x4 a0 = *(const f32x4*)(OG + ((size_t)0 * MTOK + row) * 256 + lane * 4), a1 = *(const f32x4*)(OG + ((size_t)1 * MTOK + row) * 256 + lane * 4), a2 = *(const f32x4*)(OG + ((size_t)2 * MTOK + row) * 256 + lane * 4);
            const f32x4 o = a0 * w0 + a1 * w1 + a2 * w2;
            *(unsigned long long*)(BR + (size_t)row * NBR + lane * 4) = (unsigned long long)pk2(o.x, o.y) | ((unsigned long long)pk2(o.z, o.w) << 32);
        }
    }
}

__device__ __forceinline__ void mix_phase_c(const Frame& F) {
    unsigned char* ws = ws_ptr(F);
    const bf16* COLS = (const bf16*)(ws + WS_COLS); const float* OC = (const float*)(ws + WS_OC); const float* OW = (const float*)(ws + WS_OW);
    const unsigned* SEL = (const unsigned*)(ws + WS_SEL); bf16* BR = (bf16*)(ws + WS_BR);
    const int lane = F.lane;
    for (int u = F.bx; u < 512; u += F.G) { const int v = u & 255; att::SlcPol pol; pol.init(ws, (v & 7) >> 1, v & 1, u < 256 ? 31 - (v >> 3) : (v >> 3), (F.wave & 3) * 16 + (lane & 15), u < 256 ? 0 : 2); if (u < 256) att::attn_unit3<2>(F, pol); else att::attn_unit3<1>(F, pol); }
}

#ifndef PROBE_TWICE_MASK
#define PROBE_TWICE_MASK 0
#endif
#define PH_SITE(site, ...) if (ph >= lo && ph < hi) { { const Frame F = make_frame(ldsp, nullptr); __VA_ARGS__ if (ph + 1 < hi || ((PROBE_TWICE_MASK >> (site)) & 1)) { xcd_barrier(bar); if (PROBE_BAR2) xcd_barrier(bar); } } \
        if ((PROBE_TWICE_MASK >> (site)) & 1) { const Frame F = make_frame(ldsp, nullptr); __VA_ARGS__ if (ph + 1 < hi) xcd_barrier(bar); } } ++ph;
#define WSP(off) (ws_ptr(F) + (off))
template <int l> __device__ __forceinline__ void layer_phases(LAS unsigned char* const ldsp, const int lo, const int hi, int& ph, const XcdBarrier& bar) {
        PH_SITE(1,
        { unsigned char* ws = ws_ptr(F); unsigned char* wl = ws + WS_W + (size_t)l * W_LAYER;
          pg8::Gemm g{(const bf16*)(ws + WS_XN), (const bf16*)(wl + WO_WI1), MTOK, 2 * DFF, DM, DM, DM}; pg8::StaticOrder S; S.init(MTOK, 2 * DFF, F.G, F.bx, WGM_WIDE);
          pg8::EpiSwiglu E{(bf16*)(ws + WS_H), DFF}; pg8::gemm_phase<pg8::EpiSwiglu, pg8::StaticOrder, true, true>(F.lds + RING_OFF, g, S, E);
          if (MK_FILLER) tr_filler(F, TR_PRO + l * FILL_L, FILL_A, (32 * 44) % 256); }
        )
        PH_SITE(2,
        { unsigned char* ws = ws_ptr(F); unsigned char* wl = ws + WS_W + (size_t)l * W_LAYER; float* X = out_ptr(F);
          pg8::Gemm g{(const bf16*)(ws + WS_H), (const bf16*)(wl + WO_WO1), MTOK, DM, DFF, DFF, DFF}; pg8::StaticOrder S; S.init(MTOK, DM, F.G, F.bx, WGM_NARROW);
          pg8::EpiRes E{l == 0 ? in_ptr(F, 0) : X, X, DM, 0.5f}; pg8::gemm_phase<pg8::EpiRes, pg8::StaticOrder, true, true>(F.lds + RING_OFF, g, S, E); }
        )
        PH_SITE(3,
        rmsnorm_rows_bf16(F, out_ptr(F), in_ptr(F, 4) + (size_t)l * DM, (bf16*)WSP(WS_XN));
        )
        PH_SITE(4,
        { unsigned char* ws = ws_ptr(F); unsigned char* wl = ws + WS_W + (size_t)l * W_LAYER;
          pg8::Gemm g{(const bf16*)(ws + WS_XN), (const bf16*)(wl + WO_WIN), MTOK, NCOLS, DM, DM, DM}; pg8::StaticOrder S; S.init(MTOK, NCOLS, F.G, F.bx, WGM_WIDE);
          pg8::EpiCols E{(bf16*)(ws + WS_COLS), NCOLS, SIG_TILE}; pg8::gemm_phase<pg8::EpiCols, pg8::StaticOrder, true, true>(F.lds + RING_OFF, g, S, E);
          if (MK_FILLER) tr_filler(F, TR_PRO + l * FILL_L + FILL_A, FILL_B, (32 * 45) % 256); }
        )
        PH_SITE(5,
        mix_phase_a(F, l);
        )
        PH_SITE(6,
        mix_phase_b(F);
        )
        PH_SITE(7,
        mix_phase_c(F);
        )
        PH_SITE(8,
        { unsigned char* ws = ws_ptr(F); unsigned char* wl = ws + WS_W + (size_t)l * W_LAYER;
          const bf16* BR = (const bf16*)(ws + WS_BR); const bf16* PT = (const bf16*)(wl + WO_PROJ); const bf16* GM = (const bf16*)(ws + WS_COLS) + C_GM; float* ZF = (float*)(ws + WS_ZF); bf16* Z = (bf16*)(ws + WS_Z);
          pg8::StaticOrder S; S.init(MTOK, DM, F.G, F.bx, WGM_NARROW);
          { pg8::Gemm g{BR, PT, MTOK, DM, NBR, NBR, NBR}; pg8::EpiProjF E{GM, NCOLS, Z, DM, 4, 12}; pg8::gemm_phase<pg8::EpiProjF, pg8::StaticOrder, true, true>(F.lds + RING_OFF, g, S, E); }
        }
        )
        PH_SITE(9,
        { unsigned char* ws = ws_ptr(F); unsigned char* wl = ws + WS_W + (size_t)l * W_LAYER; float* X = out_ptr(F);
          pg8::Gemm g{(const bf16*)(ws + WS_Z), (const bf16*)(wl + WO_WOUT), MTOK, DM, DM, DM, DM}; pg8::StaticOrder S; S.init(MTOK, DM, F.G, F.bx, WGM_NARROW);
          pg8::EpiRes E{X, X, DM, 1.0f}; pg8::gemm_phase<pg8::EpiRes, pg8::StaticOrder, true, true>(F.lds + RING_OFF, g, S, E); }
        )
        PH_SITE(10,
        rmsnorm_rows_bf16(F, out_ptr(F), in_ptr(F, 18) + (size_t)l * DM, (bf16*)WSP(WS_XN));
        )
        PH_SITE(11,
        { unsigned char* ws = ws_ptr(F); unsigned char* wl = ws + WS_W + (size_t)l * W_LAYER;
          pg8::Gemm g{(const bf16*)(ws + WS_XN), (const bf16*)(wl + WO_WI2), MTOK, 2 * DFF, DM, DM, DM}; pg8::StaticOrder S; S.init(MTOK, 2 * DFF, F.G, F.bx, WGM_WIDE);
          pg8::EpiSwiglu E{(bf16*)(ws + WS_H), DFF}; pg8::gemm_phase<pg8::EpiSwiglu, pg8::StaticOrder, true, true>(F.lds + RING_OFF, g, S, E);
          if (MK_FILLER) tr_filler(F, TR_PRO + l * FILL_L + FILL_A + FILL_B, FILL_C, (32 * 44) % 256); }
        )
        PH_SITE(12,
        { unsigned char* ws = ws_ptr(F); unsigned char* wl = ws + WS_W + (size_t)l * W_LAYER; float* X = out_ptr(F);
          pg8::Gemm g{(const bf16*)(ws + WS_H), (const bf16*)(wl + WO_WO2), MTOK, DM, DFF, DFF, DFF}; pg8::StaticOrder S; S.init(MTOK, DM, F.G, F.bx, WGM_NARROW);
          pg8::EpiRes E{X, X, DM, 0.5f}; pg8::gemm_phase<pg8::EpiRes, pg8::StaticOrder, true, true>(F.lds + RING_OFF, g, S, E); }
        )
        PH_SITE(13,
        if (l + 1 < DEPTH) rmsnorm_rows_bf16(F, out_ptr(F), in_ptr(F, 1) + (size_t)(l + 1) * DM, (bf16*)WSP(WS_XN));
        else rmsnorm_rows_f32(F, out_ptr(F), in_ptr(F, 21), out_ptr(F));
        )
}
#undef PH_SITE
#undef WSP

__global__ void __launch_bounds__(NWAVES * 64, 2) trunk_fwd(Args args) {
    extern __shared__ __attribute__((aligned(16))) unsigned char lds[];
    LAS unsigned char* const ldsp = (LAS unsigned char*)lds;
    {
        const int tid = threadIdx.x;
        for (int u = tid; u < (LDS_BYTES - LDSCTL_OFF) / 4; u += NWAVES * 64) ((LAS unsigned*)(ldsp + LDSCTL_OFF))[u] = 0u;
        __syncthreads();
        if (tid == 0) { volatile LAS unsigned long long* tab = (volatile LAS unsigned long long*)(ldsp + LDSCTL_OFF);
#pragma unroll
            for (int i = 0; i < 22; ++i) tab[i] = (unsigned long long)args.in[i];
            tab[22] = (unsigned long long)args.out; tab[23] = (unsigned long long)args.ws; }
        __syncthreads();
    }
    const int lo = args.ph_lo, hi = args.ph_hi;
    XcdBarrier bar; bar.bar = (unsigned*)(args.ws + WS_CTL) + CW_BAR; bar.x = 0; bar.st = nullptr;
    if (hi - lo > 1) bar = xcd_barrier_post((unsigned*)(args.ws + WS_CTL) + CW_BAR, (volatile LAS unsigned*)(ldsp + MISC_OFF) + 8);
    int ph = 0;
#ifndef PROBE_TWICE_MASK
#define PROBE_TWICE_MASK 0
#endif
#define PH_SITE(site, ...) if (ph >= lo && ph < hi) { { const Frame F = make_frame(ldsp, nullptr); __VA_ARGS__ if (ph + 1 < hi || ((PROBE_TWICE_MASK >> (site)) & 1)) { xcd_barrier(bar); if (PROBE_BAR2) xcd_barrier(bar); } } \
        if ((PROBE_TWICE_MASK >> (site)) & 1) { const Frame F = make_frame(ldsp, nullptr); __VA_ARGS__ if (ph + 1 < hi) xcd_barrier(bar); } } ++ph;
#define WSP(off) (ws_ptr(F) + (off))

    PH_SITE(0,
    {
        unsigned char* ws = ws_ptr(F);
        tr_run(F, ws, F.gw, TR_PRO, F.NGW);
        rmsnorm_rows_bf16(F, in_ptr(F, 0), in_ptr(F, 1), (bf16*)(ws + WS_XN));
    }
    )

    layer_phases<0>(ldsp, lo, hi, ph, bar); layer_phases<1>(ldsp, lo, hi, ph, bar); layer_phases<2>(ldsp, lo, hi, ph, bar); layer_phases<3>(ldsp, lo, hi, ph, bar);
#undef PH_SITE
#undef WSP
}

#ifndef MK_ONE_LAUNCH
#define MK_ONE_LAUNCH 1
#endif
extern "C" void kernel_launch(void* const* d_in, const int* in_sizes, int n_in, void* d_out, int out_size, void* d_ws, size_t ws_size, hipStream_t stream) {
    static int grid = 0;
    if (grid == 0) {
        if (n_in != 22 || in_sizes[0] != MTOK * DM || out_size != MTOK * DM || ws_size < WS_END) { fprintf(stderr, "kernel_launch: unexpected shapes (n_in %d, in0 %d, out %d, ws %zu < %zu)\n", n_in, n_in > 0 ? in_sizes[0] : -1, out_size, ws_size, (size_t)WS_END); grid = -1; return; }
        int dev = 0, cus = 0, per_cu = 0;
        if (hipGetDevice(&dev) != hipSuccess || hipDeviceGetAttribute(&cus, hipDeviceAttributeMultiprocessorCount, dev) != hipSuccess) { grid = -1; return; }
        if (hipFuncSetAttribute((const void*)trunk_fwd, hipFuncAttributeMaxDynamicSharedMemorySize, LDS_BYTES) != hipSuccess) { fprintf(stderr, "kernel_launch: hipFuncSetAttribute failed\n"); grid = -1; return; }
        if (hipOccupancyMaxActiveBlocksPerMultiprocessor(&per_cu, (const void*)trunk_fwd, NWAVES * 64, LDS_BYTES) != hipSuccess || per_cu < 1) fprintf(stderr, "kernel_launch: occupancy query reports %d\n", per_cu);
        (void)hipGetLastError();
        grid = cus;
    }
    if (grid < 0) return;
    if (hipMemsetAsync((char*)d_ws + WS_CTL, 0, CTL_ZERO_BYTES, stream) != hipSuccess) return;
    Args a{};
    for (int i = 0; i < 22; ++i) a.in[i] = (const float*)d_in[i];
    a.out = (float*)d_out; a.ws = (unsigned char*)d_ws;
#if MK_ONE_LAUNCH
    a.ph_lo = 0; a.ph_hi = NPHASES;
    hipLaunchKernelGGL(trunk_fwd, dim3(grid), dim3(NWAVES * 64), LDS_BYTES, stream, a);
#else
    for (int p = 0; p < NPHASES; ++p) { a.ph_lo = p; a.ph_hi = p + 1; hipLaunchKernelGGL(trunk_fwd, dim3(grid), dim3(NWAVES * 64), LDS_BYTES, stream, a); }
#endif
}
```
